# Optimizing an MI355X kernel written in HIP

```python
import math
import jax, jax.numpy as jnp
from jax import lax
import numpy as np

D_MODEL = 1024
BATCH = 8
SEQ = 8192
DEPTH = 2

DIFF_QK_DIM = 64
DIFF_V_DIM = 2 * DIFF_QK_DIM
N_DIFF_HEADS = (D_MODEL // 2) // DIFF_V_DIM
DIFF_WIDTH = N_DIFF_HEADS * DIFF_V_DIM
SG_GROUP_DIM = 128
N_SG_GROUPS = (D_MODEL // 2) // SG_GROUP_DIM
SG_WIDTH = N_SG_GROUPS * SG_GROUP_DIM
MIX_WIDTH = DIFF_WIDTH + SG_WIDTH
CHUNK = 128
QK_COLS = N_DIFF_HEADS * 2 * DIFF_QK_DIM
IN_COLS = 2 * QK_COLS + DIFF_WIDTH + 2 * SG_WIDTH
ROPE_THETA = 10000.0
Q_BLOCK = 128
N_EXPERT_GROUPS = 4
EXPERTS_PER_GROUP = 8
N_EXPERTS = N_EXPERT_GROUPS * EXPERTS_PER_GROUP
TOP_K_IN_GROUP = 2
D_EXPERT = 512
DEEPNORM_ALPHA = (2.0 * DEPTH) ** 0.25
DEEPNORM_BETA = (8.0 * DEPTH) ** -0.25
LN_EPS = 1e-5
ADA_SCALE = 0.1

kernel_name = "hymba_diffattn_sgmlp_hmoe_deepnorm"


def layer_norm(x, g, b):
    xf = x.astype(jnp.float32)
    mu = jnp.mean(xf, axis=-1, keepdims=True)
    var = jnp.mean(jnp.square(xf - mu), axis=-1, keepdims=True)
    return ((xf - mu) * lax.rsqrt(var + LN_EPS) * g + b).astype(x.dtype)


def rms_norm(x, g):
    xf = x.astype(jnp.float32)
    return (xf * lax.rsqrt(jnp.mean(jnp.square(xf), axis=-1, keepdims=True) + LN_EPS) * g).astype(x.dtype)


def rope_tables(seq, dim):
    inv = 1.0 / (ROPE_THETA ** (jnp.arange(0, dim, 2, dtype=jnp.float32) / dim))
    ang = jnp.arange(seq, dtype=jnp.float32)[:, None] * inv[None, :]
    return jnp.cos(ang), jnp.sin(ang)


def apply_rope(t, cos, sin):
    t1, t2 = jnp.split(t, 2, axis=-1)
    c = cos[:, None, None, :].astype(t.dtype)
    s = sin[:, None, None, :].astype(t.dtype)
    return jnp.concatenate([t1 * c - t2 * s, t2 * c + t1 * s], axis=-1)


def diff_attention(q, k, v, lam):
    B, S, H, _, dk = q.shape
    nb = S // Q_BLOCK
    qb = (q * (dk ** -0.5)).reshape(B, nb, Q_BLOCK, H, 2, dk).transpose(1, 0, 2, 3, 4, 5)
    kpos = jnp.arange(S)

    def one_block(args):
        qblk, i = args
        s = jnp.einsum('bqhmd,bkhmd->bhmqk', qblk, k).astype(jnp.float32)
        qpos = i * Q_BLOCK + jnp.arange(Q_BLOCK)
        s = jnp.where(kpos[None, :] <= qpos[:, None], s, -jnp.inf)
        p = jax.nn.softmax(s, axis=-1)
        a = p[:, :, 0] - lam * p[:, :, 1]
        return jnp.einsum('bhqk,bkhd->bqhd', a.astype(v.dtype), v)

    out = lax.map(one_block, (qb, jnp.arange(nb)))
    return out.transpose(1, 0, 2, 3, 4).reshape(B, S, H, v.shape[-1])


def chunk_spatial_gate(zu, zv, ln_g, ln_b, w_s, b_s):
    B, S, G, C = zv.shape
    zv = layer_norm(zv, ln_g, ln_b)
    causal = jnp.tril(jnp.ones((CHUNK, CHUNK), dtype=bool))
    w = jnp.where(causal[None], w_s, jnp.zeros_like(w_s))
    zc = zv.reshape(B, S // CHUNK, CHUNK, G, C)
    mixed = jnp.einsum('gts,bnsgc->bntgc', w, zc) + b_s.T[None, None, :, :, None]
    return zu * mixed.reshape(B, S, G, C)


def hier_moe(h, w_grp, b_grp, w_rt, b_rt, w_gate, w_up, w_down):
    B, S, D = h.shape
    t = h.reshape(-1, D)
    T = t.shape[0]
    grp_logits = (t @ w_grp + b_grp).astype(jnp.float32)
    grp_prob = jax.nn.softmax(grp_logits, axis=-1)
    g_idx = jnp.argmax(grp_logits, axis=-1)
    g_p = jnp.take_along_axis(grp_prob, g_idx[:, None], axis=-1)[:, 0]
    exp_logits = (jnp.einsum('td,gde->tge', t, w_rt) + b_rt).astype(jnp.float32)
    sel = jnp.take_along_axis(exp_logits, g_idx[:, None, None], axis=1)[:, 0]
    top_v, top_i = lax.top_k(sel, TOP_K_IN_GROUP)
    top_w = jax.nn.softmax(top_v, axis=-1)
    within = jnp.sum(jax.nn.one_hot(top_i, EXPERTS_PER_GROUP, dtype=jnp.float32) * top_w[..., None], axis=1)
    grp_w = jax.nn.one_hot(g_idx, N_EXPERT_GROUPS, dtype=jnp.float32) * g_p[:, None]
    combine = (grp_w[:, :, None] * within[:, None, :]).reshape(T, N_EXPERTS).astype(t.dtype)
    out = jnp.zeros_like(t)
    for e in range(N_EXPERTS):
        a = jax.nn.silu(t @ w_gate[e]) * (t @ w_up[e])
        out = out + combine[:, e:e + 1] * (a @ w_down[e])
    return out.reshape(B, S, D)


def setup_inputs(seed: int = 0) -> dict:
    key = jax.random.key(seed)
    ks = jax.random.split(key, 32)
    n = jax.random.normal
    f32 = jnp.float32
    D, L = D_MODEL, DEPTH
    w_in = n(ks[2], (L, D, IN_COLS), f32) * D ** -0.5
    v0, v1 = 2 * QK_COLS, 2 * QK_COLS + DIFF_WIDTH + SG_WIDTH
    col_scale = jnp.ones((IN_COLS,), f32).at[v0:v1].set(DEEPNORM_BETA)
    w_in = w_in * col_scale
    return {
        "x": n(ks[0], (BATCH, SEQ, D), f32),
        "c": n(ks[1], (BATCH, D), f32),
        "w_ada": n(ks[3], (L, D, 6 * D), f32) * (D ** -0.5) * ADA_SCALE,
        "b_ada": n(ks[4], (L, 6 * D), f32) * 0.02,
        "w_in": w_in,
        "lambda_q1": n(ks[5], (L, DIFF_QK_DIM), f32) * 0.1,
        "lambda_k1": n(ks[6], (L, DIFF_QK_DIM), f32) * 0.1,
        "lambda_q2": n(ks[7], (L, DIFF_QK_DIM), f32) * 0.1,
        "lambda_k2": n(ks[8], (L, DIFF_QK_DIM), f32) * 0.1,
        "subln_g": 1.0 + 0.02 * n(ks[9], (L, DIFF_V_DIM), f32),
        "sg_ln_g": 1.0 + 0.02 * n(ks[10], (L, N_SG_GROUPS, SG_GROUP_DIM), f32),
        "sg_ln_b": 0.02 * n(ks[11], (L, N_SG_GROUPS, SG_GROUP_DIM), f32),
        "w_spatial": n(ks[12], (L, N_SG_GROUPS, CHUNK, CHUNK), f32) * CHUNK ** -0.5,
        "b_spatial": 1.0 + 0.02 * n(ks[13], (L, N_SG_GROUPS, CHUNK), f32),
        "w_out": n(ks[14], (L, MIX_WIDTH, D), f32) * (MIX_WIDTH ** -0.5) * DEEPNORM_BETA,
        "ln1_g": 1.0 + 0.02 * n(ks[15], (L, D), f32),
        "ln1_b": 0.02 * n(ks[16], (L, D), f32),
        "w_group": n(ks[17], (L, D, N_EXPERT_GROUPS), f32) * D ** -0.5,
        "b_group": 0.01 * n(ks[18], (L, N_EXPERT_GROUPS), f32),
        "w_router": n(ks[19], (L, N_EXPERT_GROUPS, D, EXPERTS_PER_GROUP), f32) * D ** -0.5,
        "b_router": 0.01 * n(ks[20], (L, N_EXPERT_GROUPS, EXPERTS_PER_GROUP), f32),
        "w_gate": n(ks[21], (L, N_EXPERTS, D, D_EXPERT), f32) * D ** -0.5,
        "w_up": n(ks[22], (L, N_EXPERTS, D, D_EXPERT), f32) * (D ** -0.5) * DEEPNORM_BETA,
        "w_down": n(ks[23], (L, N_EXPERTS, D_EXPERT, D), f32) * (D_EXPERT ** -0.5) * DEEPNORM_BETA,
        "ln2_g": 1.0 + 0.02 * n(ks[24], (L, D), f32),
        "ln2_b": 0.02 * n(ks[25], (L, D), f32),
    }


def reference(x, c, w_ada, b_ada, w_in, lambda_q1, lambda_k1, lambda_q2, lambda_k2, subln_g,
              sg_ln_g, sg_ln_b, w_spatial, b_spatial, w_out, ln1_g, ln1_b, w_group, b_group,
              w_router, b_router, w_gate, w_up, w_down, ln2_g, ln2_b):
    B, S, D = x.shape
    cos, sin = rope_tables(S, DIFF_QK_DIM)
    split_at = [QK_COLS, 2 * QK_COLS, 2 * QK_COLS + DIFF_WIDTH, 2 * QK_COLS + DIFF_WIDTH + SG_WIDTH]
    for l in range(DEPTH):
        mod = (jax.nn.silu(c) @ w_ada[l] + b_ada[l])[:, None, :]
        sh1, sc1, gt1, sh2, sc2, gt2 = jnp.split(mod, 6, axis=-1)

        h = x * (1 + sc1) + sh1
        proj = h @ w_in[l]
        q, k, v, u, vs = jnp.split(proj, split_at, axis=-1)
        q = apply_rope(q.reshape(B, S, N_DIFF_HEADS, 2, DIFF_QK_DIM), cos, sin)
        k = apply_rope(k.reshape(B, S, N_DIFF_HEADS, 2, DIFF_QK_DIM), cos, sin)
        v = v.reshape(B, S, N_DIFF_HEADS, DIFF_V_DIM)
        lam_init = 0.8 - 0.6 * math.exp(-0.3 * l)
        lam = (jnp.exp(jnp.sum((lambda_q1[l] * lambda_k1[l]).astype(jnp.float32)))
               - jnp.exp(jnp.sum((lambda_q2[l] * lambda_k2[l]).astype(jnp.float32))) + lam_init)
        att = diff_attention(q, k, v, lam)
        att = rms_norm(att, subln_g[l]) * (1.0 - lam_init)
        zu = jax.nn.gelu(u, approximate=False).reshape(B, S, N_SG_GROUPS, SG_GROUP_DIM)
        zv = jax.nn.gelu(vs, approximate=False).reshape(B, S, N_SG_GROUPS, SG_GROUP_DIM)
        sg = chunk_spatial_gate(zu, zv, sg_ln_g[l], sg_ln_b[l], w_spatial[l], b_spatial[l])
        mix = jnp.concatenate([att.reshape(B, S, DIFF_WIDTH), sg.reshape(B, S, SG_WIDTH)], axis=-1) @ w_out[l]
        x = layer_norm(DEEPNORM_ALPHA * x + (1 + gt1) * mix, ln1_g[l], ln1_b[l])

        h = x * (1 + sc2) + sh2
        ffn = hier_moe(h, w_group[l], b_group[l], w_router[l], b_router[l], w_gate[l], w_up[l], w_down[l])
        x = layer_norm(DEEPNORM_ALPHA * x + (1 + gt2) * ffn, ln2_g[l], ln2_b[l])
    return x
```

```cpp
#include <hip/hip_runtime.h>
#include <hip/hip_bf16.h>
#include <cstdio>
#include <cstdint>
#include <cmath>

#define LAS __attribute__((address_space(3)))
#define GAS __attribute__((address_space(1)))
typedef unsigned short bf16_t;
typedef short bf16x8 __attribute__((ext_vector_type(8)));
typedef short s16x4 __attribute__((ext_vector_type(4)));
typedef float f32x2 __attribute__((ext_vector_type(2)));
typedef float f32x4 __attribute__((ext_vector_type(4)));
typedef float f32x16 __attribute__((ext_vector_type(16)));
typedef unsigned u32x2 __attribute__((ext_vector_type(2)));
typedef unsigned u32x4 __attribute__((ext_vector_type(4)));
typedef GAS unsigned gu32;
#define RLX_AGENT __ATOMIC_RELAXED, __HIP_MEMORY_SCOPE_AGENT
#define LDS_WAIT() asm volatile("s_waitcnt lgkmcnt(0)" ::: "memory")
#define VM_WAIT() asm volatile("s_waitcnt vmcnt(0)" ::: "memory")

constexpr int NB = 8, SEQ = 8192, DM = 1024, MTOK = NB * SEQ, DEPTH = 2;
constexpr int INC = 2560;
constexpr int NEXP = 32, DEXP = 512, LCAP = 65536;
constexpr int MAXPAN = 512 + NEXP;
constexpr float LN_EPS = 1e-5f;
constexpr float ALPHA = 1.41421356237309515f;
constexpr int NWAVES = 8;

constexpr size_t MiB = 1u << 20;
constexpr size_t WS_CTL = 0, CTL_ZERO_BYTES = 1 * MiB;
constexpr size_t WS_MOD = 1 * MiB;
constexpr size_t WS_SCAL = 1 * MiB + 512 * 1024;
constexpr size_t WS_COS = 2 * MiB, WS_SIN = 3 * MiB;
constexpr size_t WS_RIMG = 4 * MiB;
constexpr size_t WS_WSP = 4 * MiB + 512 * 1024;
constexpr size_t WS_WIN = 6 * MiB;
constexpr size_t WS_WOUT = 16 * MiB;
constexpr size_t WS_WGU = 20 * MiB;
constexpr size_t WS_WD = 148 * MiB;
constexpr size_t WS_LST = 212 * MiB;
constexpr size_t WS_CW = 220 * MiB;
constexpr size_t WS_HB = 228 * MiB;
constexpr size_t WS_Q = 356 * MiB;
constexpr size_t WS_QSTRIDE = 64 * MiB;
constexpr size_t WS_O12 = 676 * MiB;
constexpr size_t WS_MIXA = 804 * MiB;
constexpr size_t WS_ACT = 356 * MiB;
constexpr size_t WS_Y2 = 492 * MiB;
constexpr size_t WS_END = 932 * MiB;
static_assert(WS_ACT + (size_t)MAXPAN * 256 * 512 * 2 <= WS_Y2 && WS_Y2 + (size_t)MTOK * 2 * 1024 * 2 <= WS_MIXA, "overlay map");
constexpr int CW_TMO = 0;
constexpr int CW_CNT = 1024;
constexpr int CW_BAR = 4096;

constexpr int RING_BYTES = 131072;
constexpr int IDX_OFF = RING_BYTES, IDX_SLOTS = 10, IDX_BYTES = IDX_SLOTS * 1024;
constexpr int PPRE_OFF = IDX_OFF + IDX_BYTES;
constexpr int LDSCTL_OFF = PPRE_OFF + 512, MISC_OFF = LDSCTL_OFF + 64;
constexpr int LDS_BYTES = 147456;
static_assert(MISC_OFF + 128 <= LDS_BYTES, "LDS map");

__device__ __forceinline__ unsigned cvtpk(float lo, float hi) { f32x2 v = {lo, hi}; typedef __bf16 bf2 __attribute__((ext_vector_type(2))); bf2 b = __builtin_convertvector(v, bf2); return __builtin_bit_cast(unsigned, b); }
__device__ __forceinline__ float bf2f(unsigned short b) { return __uint_as_float((unsigned)b << 16); }
__device__ __forceinline__ float bflo(unsigned w) { return __uint_as_float(w << 16); }
__device__ __forceinline__ float bfhi(unsigned w) { return __uint_as_float(w & 0xffff0000u); }
__device__ __forceinline__ float wave_sum(float v) {
#pragma unroll
    for (int o = 1; o < 64; o <<= 1) v += __shfl_xor(v, o);
    return v;
}
__device__ __forceinline__ f32x2 gelu_pk(f32x2 v) {
    const f32x2 av = __builtin_elementwise_abs(v), d = av * 0.2316418882f + 1.0f;
    f32x2 t; t.x = __builtin_amdgcn_rcpf(d.x); t.y = __builtin_amdgcn_rcpf(d.y);
    f32x2 q = t * 0.5307027145f + (-0.7265760135f); q = q * t + 0.7107068705f; q = q * t + (-0.142248368f); q = q * t + 0.127414796f; q = q * t;
    const f32x2 s = (v * v) * (-0.72134752044f);
    f32x2 e; e.x = __builtin_amdgcn_exp2f(s.x); e.y = __builtin_amdgcn_exp2f(s.y);
    const f32x2 m = v * (q * e), r = v - m;
    f32x2 o; o.x = v.x < 0.f ? m.x : r.x; o.y = v.y < 0.f ? m.y : r.y; return o;
}
__device__ __forceinline__ f32x4 gelu4(f32x4 v) { const f32x2 a = gelu_pk((f32x2){v[0], v[1]}), b = gelu_pk((f32x2){v[2], v[3]}); return (f32x4){a.x, a.y, b.x, b.y}; }
__device__ __forceinline__ float silu1(float x) { return x * __builtin_amdgcn_rcpf(1.0f + __builtin_amdgcn_exp2f(-1.4426950408889634f * x)); }
namespace pg8 {
constexpr int BM = 256, BK = 64, HALF = 128, HTB = HALF * BK * 2, STAGE_BYTES = 8 * HTB, NXCD = 8, WGM = 8;
__device__ __forceinline__ int lds_byte(int r, int c) { const int st = (r >> 4) * 2 + (c >> 5), rr = r & 15, cc = c & 31, ob = rr * 64 + cc * 2; return st * 1024 + (ob ^ (((ob >> 9) & 1) << 5)); }
__device__ __forceinline__ void stage_rc(int b, int& R, int& C) { const int st = b / 1024, sb = b % 1024, swz = sb ^ (((sb >> 9) & 1) << 5); R = (st >> 1) * 16 + swz / 64; C = (st & 1) * 32 + (swz % 64) / 2; }

struct Unit { const char* A; const char* B; int pm, pn, e, nrows, row0, slot; };

struct DenseOrder {
    int nM, nN, nwg, G, c; const char* A; const char* B; size_t tstep;
    __device__ void init(const void* A_, const void* B_, int Mrows, int N, int K, int G_, int c_) { nM = Mrows / BM; nN = N / BM; nwg = nM * nN; G = G_; c = c_; A = (const char*)A_; B = (const char*)B_; tstep = (size_t)BM * K * 2; }
    __device__ bool next(int i, Unit& u) const {
        const long L = (long)i * G + c; if (L >= nwg) return false;
        int wgid = (int)L; { const int q = nwg / NXCD, r = nwg % NXCD, xcd = wgid % NXCD, off = wgid / NXCD; wgid = (xcd < r ? xcd * (q + 1) : r * (q + 1) + (xcd - r) * q) + off; }
        const int nig = WGM * nN, gid = wgid / nig, fm = gid * WGM, gsz = (nM - fm) < WGM ? (nM - fm) : WGM;
        u.pm = fm + ((wgid % nig) % gsz); u.pn = (wgid % nig) / gsz; u.e = 0; u.nrows = 256; u.row0 = 0; u.slot = 0;
        u.A = A + (size_t)u.pm * tstep; u.B = B + (size_t)u.pn * tstep; return true;
    }
};
struct ExpertOrder {
    const LAS int* ppre; const LAS int* cnt; int TP, G, c; const char* A; const char* B; size_t a_tstep, b_estride, b_tstep; bool gather;
    __device__ bool next(int i, Unit& u) const {
        const int L = i * G + c; if (L >= 4 * TP) return false;
        const int p = L >> 2; int e = 0;
        while (e < NEXP - 1 && ppre[e + 1] <= p) ++e;
        u.pm = p; u.pn = L & 3; u.e = e; u.row0 = (p - ppre[e]) * 256; { const int rem = cnt[e] - u.row0; u.nrows = rem < 256 ? rem : 256; } u.slot = i;
        u.A = gather ? A : A + (size_t)p * a_tstep; u.B = B + (size_t)e * b_estride + (size_t)u.pn * b_tstep; return true;
    }
};

template <class Epi, class Sched, bool GATHER>
__device__ __forceinline__ void gemm_phase(LAS unsigned char* lds, const int K, const LAS unsigned* gidx, const Sched& S, const Epi& E) {
    int tid_ = threadIdx.x; asm volatile("" : "+v"(tid_));
    const int tid = tid_, wid = __builtin_amdgcn_readfirstlane(tid >> 6), lane = tid & 63, wr = wid >> 2, wc = wid & 3, fr = lane & 15, fq = lane >> 4;
    const int nt = K / BK;
    unsigned voff[2]; int rA[2]; unsigned cA2[2];
#pragma unroll
    for (int i = 0; i < 2; ++i) { int R, C; stage_rc(tid * 16 + i * 8192, R, C); voff[i] = (unsigned)(R * K + C) * 2u; rA[i] = R; cA2[i] = (unsigned)C * 2u; }
    const size_t kstep = (size_t)(BK * 2);
    const size_t hstep = (size_t)HALF * K * 2;
    const unsigned ldsw = (unsigned)wid * 1024u;
    const int aoff = lds_byte(wr * 64 + fr, fq * 8), boff = lds_byte(wc * 32 + fr, fq * 8);
#define PG8_SA(b, h) (((b) * 2 + (h)) * HTB)
#define PG8_SB(b, h) ((4 + (b) * 2 + (h)) * HTB)
#define PG8_STAGE_B(bufoff, gbase) do { _Pragma("unroll") for (int _i = 0; _i < 2; ++_i) \
        __builtin_amdgcn_global_load_lds((const unsigned*)((const char*)(gbase) + voff[_i]), (LAS unsigned*)(lds + (bufoff) + ldsw + _i * 8192), 16, 0, 0); } while (0)
#define PG8_STAGE_A(bufoff, h, uptr, NEXT) do { _Pragma("unroll") for (int _i = 0; _i < 2; ++_i) { \
        const unsigned _vo = GATHER ? ((NEXT) ? ngo[h][_i] : cgo[h][_i]) : voff[_i]; \
        __builtin_amdgcn_global_load_lds((const unsigned*)((const char*)(uptr) + (GATHER ? (size_t)0 : (size_t)(h) * hstep) + _vo), (LAS unsigned*)(lds + (bufoff) + ldsw + _i * 8192), 16, 0, 0); } } while (0)
#define PG8_LDA(dst, b, h) do { _Pragma("unroll") for (int m = 0; m < 4; ++m) _Pragma("unroll") for (int k = 0; k < 2; ++k) dst[m][k] = *(const LAS bf16x8*)(lds + PG8_SA(b, h) + aoff + m * 2048 + k * 1024); } while (0)
#define PG8_LDB(dst, b, h) do { _Pragma("unroll") for (int n = 0; n < 2; ++n) _Pragma("unroll") for (int k = 0; k < 2; ++k) dst[n][k] = *(const LAS bf16x8*)(lds + PG8_SB(b, h) + boff + n * 2048 + k * 1024); } while (0)
#define PG8_MMA(ai, bj, At, Bt) do { __builtin_amdgcn_s_setprio(1); _Pragma("unroll") for (int m = 0; m < 4; ++m) _Pragma("unroll") for (int n = 0; n < 2; ++n) _Pragma("unroll") for (int k = 0; k < 2; ++k) \
        acc[ai][bj][m][n] = __builtin_amdgcn_mfma_f32_16x16x32_bf16(Bt[n][k], At[m][k], acc[ai][bj][m][n], 0, 0, 0); __builtin_amdgcn_s_setprio(0); } while (0)
#define PG8_WAIT_V(n) asm volatile("s_waitcnt vmcnt(" #n ")" ::: "memory")
#define PG8_WAIT_L(n) asm volatile("s_waitcnt lgkmcnt(" #n ")" ::: "memory")
#define PG8_BAR __builtin_amdgcn_s_barrier()
#define PG8_SCHED __builtin_amdgcn_sched_barrier(0)
#define PG8_GO(dst, slot) do { if constexpr (GATHER) { _Pragma("unroll") for (int _h = 0; _h < 2; ++_h) _Pragma("unroll") for (int _i = 0; _i < 2; ++_i) \
        dst[_h][_i] = gidx[(slot) * 256 + _h * 128 + rA[_i]] * (unsigned)(K * 2) + cA2[_i]; } } while (0)
    Unit cur, nxt; int ui = 0;
    if (!S.next(0, cur)) return;
    unsigned cgo[2][2] = {{0u, 0u}, {0u, 0u}}, ngo[2][2] = {{0u, 0u}, {0u, 0u}};
    PG8_GO(cgo, cur.slot);
    f32x4 acc[2][2][4][2];
#pragma unroll
    for (int a = 0; a < 2; ++a)
#pragma unroll
        for (int b = 0; b < 2; ++b)
#pragma unroll
            for (int m = 0; m < 4; ++m)
#pragma unroll
                for (int n = 0; n < 2; ++n) acc[a][b][m][n] = (f32x4){0.f, 0.f, 0.f, 0.f};
    bf16x8 At[4][2], B0[2][2], B1[2][2];
    const char* cA = cur.A; const char* cB = cur.B;
    PG8_STAGE_B(PG8_SB(0, 0), cB); PG8_STAGE_B(PG8_SB(0, 1), cB + hstep); PG8_STAGE_A(PG8_SA(0, 0), 0, cA, false); PG8_STAGE_A(PG8_SA(0, 1), 1, cA, false);
    if (wr == 1) PG8_BAR;
    PG8_WAIT_V(2); PG8_BAR;
    PG8_STAGE_B(PG8_SB(1, 0), cB + kstep); PG8_STAGE_A(PG8_SA(1, 0), 0, cA + kstep, false); PG8_STAGE_B(PG8_SB(1, 1), cB + hstep + kstep);
    PG8_WAIT_V(6); PG8_BAR;
    for (;;) {
        const bool has_next = S.next(ui + 1, nxt);
        const char* nA = has_next ? nxt.A : cA; const char* nB = has_next ? nxt.B : cB;
        if constexpr (GATHER) { if (has_next) { PG8_GO(ngo, nxt.slot); } else {
#pragma unroll
            for (int h = 0; h < 2; ++h)
#pragma unroll
                for (int i = 0; i < 2; ++i) ngo[h][i] = cgo[h][i]; } }
        for (int t = 0; t < nt; t += 2) {
            const bool last = (t == nt - 2);
            const char* a1 = cA + (size_t)(t + 1) * kstep;
            const char* a2 = last ? nA : cA + (size_t)(t + 2) * kstep; const char* b2 = last ? nB : cB + (size_t)(t + 2) * kstep;
            const char* a3 = a2 + kstep; const char* b3 = b2 + kstep;
            PG8_LDB(B0, 0, 0); PG8_LDB(B1, 0, 1); PG8_SCHED; PG8_LDA(At, 0, 0); PG8_STAGE_A(PG8_SA(1, 1), 1, a1, false);
            PG8_WAIT_V(8); PG8_WAIT_L(0); PG8_BAR; PG8_MMA(0, 0, At, B0); PG8_MMA(0, 1, At, B1); PG8_BAR; PG8_SCHED;
            PG8_LDA(At, 0, 1); PG8_STAGE_B(PG8_SB(0, 0), b2); PG8_STAGE_B(PG8_SB(0, 1), b2 + hstep); PG8_STAGE_A(PG8_SA(0, 0), 0, a2, last);
            PG8_WAIT_V(8); PG8_WAIT_L(0); PG8_BAR; PG8_MMA(1, 0, At, B0); PG8_MMA(1, 1, At, B1); PG8_BAR; PG8_SCHED;
            PG8_LDB(B0, 1, 0); PG8_LDB(B1, 1, 1); PG8_SCHED; PG8_LDA(At, 1, 0); PG8_STAGE_A(PG8_SA(0, 1), 1, a2, last);
            PG8_WAIT_V(8); PG8_WAIT_L(0); PG8_BAR; PG8_MMA(0, 0, At, B0); PG8_MMA(0, 1, At, B1); PG8_BAR; PG8_SCHED;
            PG8_LDA(At, 1, 1); PG8_STAGE_B(PG8_SB(1, 0), b3); PG8_STAGE_B(PG8_SB(1, 1), b3 + hstep); PG8_STAGE_A(PG8_SA(1, 0), 0, a3, last);
            PG8_WAIT_V(8); PG8_WAIT_L(0); PG8_BAR; PG8_MMA(1, 0, At, B0); PG8_MMA(1, 1, At, B1); PG8_BAR; PG8_SCHED;
        }
        if (wr == 0) PG8_BAR;
        E(acc, cur, wr, wc, fr, fq);
        if (!has_next) break;
#pragma unroll
        for (int a = 0; a < 2; ++a)
#pragma unroll
            for (int b = 0; b < 2; ++b)
#pragma unroll
                for (int m = 0; m < 4; ++m)
#pragma unroll
                    for (int n = 0; n < 2; ++n) acc[a][b][m][n] = (f32x4){0.f, 0.f, 0.f, 0.f};
        cur = nxt; cA = nA; cB = nB; ++ui;
        if constexpr (GATHER) {
#pragma unroll
            for (int h = 0; h < 2; ++h)
#pragma unroll
                for (int i = 0; i < 2; ++i) cgo[h][i] = ngo[h][i]; }
        if (wr == 1) PG8_BAR;
    }
    PG8_WAIT_V(0);
    PG8_BAR;
#undef PG8_SA
#undef PG8_SB
#undef PG8_STAGE_A
#undef PG8_STAGE_B
#undef PG8_LDA
#undef PG8_LDB
#undef PG8_MMA
#undef PG8_WAIT_V
#undef PG8_WAIT_L
#undef PG8_BAR
#undef PG8_SCHED
#undef PG8_GO
}

__device__ __forceinline__ u32x4 pack8(f32x4 a, f32x4 b) { u32x4 w; w.x = cvtpk(a[0], a[1]); w.y = cvtpk(a[2], a[3]); w.z = cvtpk(b[0], b[1]); w.w = cvtpk(b[2], b[3]); return w; }

struct EpiInProj {
    bf16_t* out0; size_t type_stride; const float* cosT; const float* sinT; float qscale;
    __device__ __forceinline__ void operator()(const f32x4 (&acc)[2][2][4][2], const Unit& u, int wr, int wc, int fr, int fq) const {
        const int type = u.pn >> 1;
        bf16_t* base = out0 + (size_t)type * type_stride + (u.pn & 1) * 256 + wc * 32 + fq * 8;
        const int row0 = u.pm * BM + wr * 64 + fr;
        if (type <= 1) {
            const float sc = (type == 0) ? qscale : 1.0f;
            const int ci = 16 * (wc & 1) + 4 * fq;
#pragma unroll
            for (int ai = 0; ai < 2; ++ai)
#pragma unroll
                for (int m = 0; m < 4; ++m) { const int row = row0 + ai * HALF + m * 16; const int pos = row & (SEQ - 1);
                    const f32x4 cs = *(const f32x4*)(cosT + pos * 32 + ci) * sc, sn = *(const f32x4*)(sinT + pos * 32 + ci) * sc;
                    bf16_t* rowp = base + (size_t)row * 512;
#pragma unroll
                    for (int bj = 0; bj < 2; ++bj) { const f32x4 x1 = acc[ai][bj][m][0], x2 = acc[ai][bj][m][1];
                        *(u32x4*)(rowp + bj * HALF) = pack8(x1 * cs - x2 * sn, x2 * cs + x1 * sn); } }
        } else if (type == 2) {
#pragma unroll
            for (int ai = 0; ai < 2; ++ai)
#pragma unroll
                for (int m = 0; m < 4; ++m) { bf16_t* rowp = base + (size_t)(row0 + ai * HALF + m * 16) * 512;
#pragma unroll
                    for (int bj = 0; bj < 2; ++bj) *(u32x4*)(rowp + bj * HALF) = pack8(acc[ai][bj][m][0], acc[ai][bj][m][1]); }
        } else {
#pragma unroll
            for (int ai = 0; ai < 2; ++ai)
#pragma unroll
                for (int m = 0; m < 4; ++m) { bf16_t* rowp = base + (size_t)(row0 + ai * HALF + m * 16) * 512;
#pragma unroll
                    for (int bj = 0; bj < 2; ++bj) *(u32x4*)(rowp + bj * HALF) = pack8(gelu4(acc[ai][bj][m][0]), gelu4(acc[ai][bj][m][1])); }
        }
    }
};
struct EpiOutProj {
    const float* xin; float* out; const float* gate;
    __device__ __forceinline__ void operator()(const f32x4 (&acc)[2][2][4][2], const Unit& u, int wr, int wc, int fr, int fq) const {
        const int b = u.pm >> 5;
        const int col0 = u.pn * BM + wc * 32 + 4 * fq; const float* gp = gate + b * 6144 + col0;
        f32x4 g[2][2];
#pragma unroll
        for (int bj = 0; bj < 2; ++bj)
#pragma unroll
            for (int n = 0; n < 2; ++n) g[bj][n] = *(const f32x4*)(gp + bj * HALF + n * 16) + 1.0f;
#pragma unroll
        for (int ai = 0; ai < 2; ++ai)
#pragma unroll
            for (int m = 0; m < 4; ++m) { const size_t off = (size_t)(u.pm * BM + ai * HALF + wr * 64 + m * 16 + fr) * DM + col0;
#pragma unroll
                for (int bj = 0; bj < 2; ++bj)
#pragma unroll
                    for (int n = 0; n < 2; ++n) { const f32x4 xi = *(const f32x4*)(xin + off + bj * HALF + n * 16);
                        *(f32x4*)(out + off + bj * HALF + n * 16) = xi * ALPHA + g[bj][n] * acc[ai][bj][m][n]; } }
    }
};
struct EpiGateUp {
    bf16_t* act;
    __device__ __forceinline__ void operator()(const f32x4 (&acc)[2][2][4][2], const Unit& u, int wr, int wc, int fr, int fq) const {
        bf16_t* base = act + (size_t)(u.pm * BM + wr * 64 + fr) * DEXP + u.pn * 128 + wc * 32 + fq * 8;
#pragma unroll
        for (int ai = 0; ai < 2; ++ai)
#pragma unroll
            for (int m = 0; m < 4; ++m) { f32x4 a[2];
#pragma unroll
                for (int bj = 0; bj < 2; ++bj) { const f32x4 g = acc[ai][bj][m][0], up = acc[ai][bj][m][1];
                    a[bj] = (f32x4){silu1(g[0]) * up[0], silu1(g[1]) * up[1], silu1(g[2]) * up[2], silu1(g[3]) * up[3]}; }
                *(u32x4*)(base + (size_t)(ai * HALF + m * 16) * DEXP) = pack8(a[0], a[1]); }
    }
};
struct EpiDown {
    bf16_t* y2; const unsigned* lst; const float* cw;
    __device__ __forceinline__ void operator()(const f32x4 (&acc)[2][2][4][2], const Unit& u, int wr, int wc, int fr, int fq) const {
        const int colb = u.pn * BM + wc * 32 + fq * 8; const size_t lb = (size_t)u.e * LCAP + u.row0;
        unsigned ent[2][4]; float w[2][4];
#pragma unroll
        for (int ai = 0; ai < 2; ++ai)
#pragma unroll
            for (int m = 0; m < 4; ++m) { const int r = ai * HALF + wr * 64 + m * 16 + fr; const bool ok = r < u.nrows;
                ent[ai][m] = ok ? lst[lb + r] : 0xffffffffu; w[ai][m] = ok ? cw[lb + r] : 0.f; }
#pragma unroll
        for (int ai = 0; ai < 2; ++ai)
#pragma unroll
            for (int m = 0; m < 4; ++m) { if (ent[ai][m] != 0xffffffffu) { bf16_t* rowp = y2 + (size_t)ent[ai][m] * DM + colb; const float ww = w[ai][m];
#pragma unroll
                for (int bj = 0; bj < 2; ++bj) *(u32x4*)(rowp + bj * HALF) = pack8(acc[ai][bj][m][0] * ww, acc[ai][bj][m][1] * ww); } }
    }
};
}
namespace att {
constexpr int NW = 8, QBLK = 32, KVBLK = 64, QB = NW * QBLK, DK = 64, DV = 128, PQ = 512, PO = 1024, NQB = SEQ / QB;
constexpr int SHM_V = KVBLK * DV * 2, SHM_K = KVBLK * DK * 2;
constexpr int LDS_BYTES = 2 * SHM_V + 2 * SHM_K + NW * 64 * 4;
constexpr float SCALE = 0.125f, THR = 8.f;
#define KSWZ(row, colB) ((row) * 128 + ((colB) ^ ((((row) >> 1) & 7) << 4)))
#define SBAR() __builtin_amdgcn_sched_barrier(0)
__device__ __forceinline__ int v_st(int k, int c) { const int kk = (k & ~0xC) | ((k & 4) << 1) | ((k & 8) >> 1); return ((kk >> 3) * 4 + (c >> 5)) * 512 + ((kk & 7) * 32 + (c & 31)) * 2; }
__device__ __forceinline__ int v_rd_base(int lane) { return ((lane & 3) << 3) | (((lane >> 2) & 3) << 6) | (((lane >> 4) & 1) << 5) | (((lane >> 5) & 1) << 8); }
constexpr int v_rd_off(int d0, int ks, int half) { return d0 * 512 + ks * 4096 + half * 2048; }
__device__ __forceinline__ int crow(int r, int hi) { return (r & 3) + 8 * (r >> 2) + 4 * hi; }
__device__ __forceinline__ bf16x8 load8(const bf16_t* p) { return *reinterpret_cast<const bf16x8*>(p); }
__device__ __forceinline__ void mask_tile(f32x16& p0, f32x16& p1, int dq) {
    const float NEG = -__builtin_inff();
#pragma unroll
    for (int r = 0; r < 16; ++r) {
        const int c = (r & 3) + 8 * (r >> 2);
        if (dq - c < 0) p0[r] = NEG;
        if (dq - c - 32 < 0) p1[r] = NEG;
    }
}
__device__ __forceinline__ void partialSM(f32x16& p0, f32x16& p1, float& m_reg, float& mn, float& alpha) {
    float pmax = p0[0];
#pragma unroll
    for (int r = 1; r < 16; ++r) pmax = fmaxf(pmax, p0[r]);
#pragma unroll
    for (int r = 0; r < 16; ++r) pmax = fmaxf(pmax, p1[r]);
    { auto rr = __builtin_amdgcn_permlane32_swap(__float_as_uint(pmax), __float_as_uint(pmax), false, false);
      pmax = fmaxf(__uint_as_float(rr[0]), __uint_as_float(rr[1])); }
    constexpr float C2 = 1.4426950408889634f * SCALE;
    if (__builtin_expect(__all((pmax - m_reg) * SCALE <= THR), 1)) { mn = m_reg; alpha = 1.f; }
    else { mn = fmaxf(m_reg, pmax); alpha = __builtin_amdgcn_exp2f((m_reg - mn) * C2); m_reg = mn; }
    const float mnL = -mn * C2;
#pragma unroll
    for (int r = 0; r < 16; ++r) p0[r] = fmaf(p0[r], C2, mnL);
#pragma unroll
    for (int r = 0; r < 16; ++r) p1[r] = fmaf(p1[r], C2, mnL);
#pragma unroll
    for (int r = 0; r < 16; ++r) p0[r] = __builtin_amdgcn_exp2f(p0[r]);
}
__device__ __forceinline__ void finishSM(f32x16& p0, f32x16& p1, float alpha, float& l_reg, bf16x8& pa0, bf16x8& pa1, bf16x8& pa2, bf16x8& pa3) {
#pragma unroll
    for (int r = 0; r < 16; ++r) p1[r] = __builtin_amdgcn_exp2f(p1[r]);
    float ps = 0;
#pragma unroll
    for (int r = 0; r < 16; ++r) ps += p0[r];
#pragma unroll
    for (int r = 0; r < 16; ++r) ps += p1[r];
    { auto rr = __builtin_amdgcn_permlane32_swap(__float_as_uint(ps), __float_as_uint(ps), false, false);
      ps = __uint_as_float(rr[0]) + __uint_as_float(rr[1]); }
    l_reg = l_reg * alpha + ps;
#define PK4(P, B_, OUT) do { unsigned a0 = cvtpk(P[B_+0], P[B_+1]), a1 = cvtpk(P[B_+2], P[B_+3]);                          \
        unsigned b0 = cvtpk(P[B_+4], P[B_+5]), b1 = cvtpk(P[B_+6], P[B_+7]);                                             \
        auto r0 = __builtin_amdgcn_permlane32_swap(a0, b0, false, false); auto r1 = __builtin_amdgcn_permlane32_swap(a1, b1, false, false); \
        u32x4 w = {r0[0], r1[0], r0[1], r1[1]}; OUT = *reinterpret_cast<bf16x8*>(&w); } while (0)
    PK4(p0, 0, pa0); PK4(p0, 8, pa1); PK4(p1, 0, pa2); PK4(p1, 8, pa3);
#undef PK4
}
template <int KB>
__device__ __forceinline__ void qkt(f32x16& p0, f32x16& p1, const char* K_lds, int r32, int hi, const bf16x8* qr) {
    p0 = f32x16{}; p1 = f32x16{};
#pragma unroll
    for (int d0 = 0; d0 < 4; ++d0) { const char* a = K_lds + KB * SHM_K + KSWZ(r32, (d0 * 16 + hi * 8) * 2);
        bf16x8 b0 = *reinterpret_cast<const bf16x8*>(a);
        bf16x8 b1 = *reinterpret_cast<const bf16x8*>(a + 32 * 128);
        p0 = __builtin_amdgcn_mfma_f32_32x32x16_bf16(b0, qr[d0], p0, 0, 0, 0);
        p1 = __builtin_amdgcn_mfma_f32_32x32x16_bf16(b1, qr[d0], p1, 0, 0, 0); }
}
template <int VB>
__device__ __forceinline__ void pv_tile(f32x16* o, int vb0, bf16x8 pa0, bf16x8 pa1, bf16x8 pa2, bf16x8 pa3) {
#define TRRD(dst, off) asm volatile("ds_read_b64_tr_b16 %0, %1 offset:%2" : "=&v"(dst) : "v"(vb0), "i"(off) : "memory")
#define PV_D0(d0) do { s16x4 l0, l1, l2, l3, h0, h1, h2, h3; constexpr int b_ = VB * SHM_V + v_rd_off(d0, 0, 0); \
        TRRD(l0, b_); TRRD(h0, b_ + 2048); TRRD(l1, b_ + 4096); TRRD(h1, b_ + 6144); TRRD(l2, b_ + 8192); TRRD(h2, b_ + 10240); TRRD(l3, b_ + 12288); TRRD(h3, b_ + 14336); \
        asm volatile("s_waitcnt lgkmcnt(0)" ::: "memory"); SBAR();   \
        o[d0] = __builtin_amdgcn_mfma_f32_32x32x16_bf16(pa0, (bf16x8){l0[0], l0[1], l0[2], l0[3], h0[0], h0[1], h0[2], h0[3]}, o[d0], 0, 0, 0);   \
        o[d0] = __builtin_amdgcn_mfma_f32_32x32x16_bf16(pa1, (bf16x8){l1[0], l1[1], l1[2], l1[3], h1[0], h1[1], h1[2], h1[3]}, o[d0], 0, 0, 0);   \
        o[d0] = __builtin_amdgcn_mfma_f32_32x32x16_bf16(pa2, (bf16x8){l2[0], l2[1], l2[2], l2[3], h2[0], h2[1], h2[2], h2[3]}, o[d0], 0, 0, 0);   \
        o[d0] = __builtin_amdgcn_mfma_f32_32x32x16_bf16(pa3, (bf16x8){l3[0], l3[1], l3[2], l3[3], h3[0], h3[1], h3[2], h3[3]}, o[d0], 0, 0, 0); } while (0)
    PV_D0(0); PV_D0(1); PV_D0(2); PV_D0(3);
#undef PV_D0
#undef TRRD
}
struct BlockRef { const bf16_t* Q; const bf16_t* K; const bf16_t* V; bf16_t* O; int P0; };
struct Seam { bf16x8 qr[4]; bf16x8 st_v0, st_v1, st_k0; };
#define VMW() asm volatile("s_waitcnt vmcnt(0)" ::: "memory")
#define VMWN(n) asm volatile("s_waitcnt vmcnt(%0)" :: "i"(n) : "memory")
#define SLOAD_H(Kp, Vp, k0) do { S.st_v0 = load8((Vp) + (size_t)((k0) + sr) * PQ + sc); S.st_v1 = load8((Vp) + (size_t)((k0) + 32 + sr) * PQ + sc); \
                                 S.st_k0 = load8((Kp) + (size_t)((k0) + krow) * PQ + kcol); } while (0)
#define SWRITE_HK(bf) do { *(bf16x8*)(K_lds + (bf) * SHM_K + kws) = S.st_k0; } while (0)
#define SWRITE_HV(bf) do { *(bf16x8*)(V_lds + (bf) * SHM_V + vst0) = S.st_v0; *(bf16x8*)(V_lds + (bf) * SHM_V + vst1) = S.st_v1; } while (0)
#define SWRITE_H(bf) do { SWRITE_HV(bf); SWRITE_HK(bf); } while (0)
__device__ __forceinline__ void prime(const BlockRef& cur, char* lds, Seam& S) {
    int tid_ = threadIdx.x; asm volatile("" : "+v"(tid_));
    const int tid = tid_, wid = __builtin_amdgcn_readfirstlane(tid >> 6), lane = tid & 63, r32 = lane & 31, hi = lane >> 5;
    const int sr = tid >> 4, sc = (tid & 15) * 8, krow = tid >> 3, kcol = (tid & 7) * 8, kws = KSWZ(krow, kcol * 2); char* K_lds = lds + 2 * SHM_V;
#pragma unroll
    for (int d0 = 0; d0 < 4; ++d0) S.qr[d0] = load8(cur.Q + (size_t)(wid * QBLK + r32) * PQ + d0 * 16 + hi * 8);
    SLOAD_H(cur.K, cur.V, 0); VMW(); SWRITE_HK(0);
    __syncthreads();
}
__device__ __forceinline__ void block(const BlockRef& cur, const BlockRef& nxt, char* lds, Seam& S) {
    int tid_ = threadIdx.x; asm volatile("" : "+v"(tid_));
    const int tid = tid_, wid = __builtin_amdgcn_readfirstlane(tid >> 6), lane = tid & 63, r32 = lane & 31, hi = lane >> 5;
    const int NT = (cur.P0 + QB) / KVBLK;
    const int qlo = cur.P0 + wid * QBLK, qm = qlo + r32 - 4 * hi;
    char* V_lds = lds; char* K_lds = lds + 2 * SHM_V;
    float* ws = (float*)(lds + 2 * SHM_V + 2 * SHM_K) + wid * 64; float* li_l = ws, * al_l = ws + 32;
    float m_reg = -1e30f, l_reg = 0; f32x16 o[4] = {};
    const int sr = tid >> 4, sc = (tid & 15) * 8, vst0 = v_st(sr, sc), vst1 = v_st(32 + sr, sc);
    const int krow = tid >> 3, kcol = (tid & 7) * 8, kws = KSWZ(krow, kcol * 2);
    const int vb0 = (int)(uintptr_t)V_lds + v_rd_base(lane);
    const bf16_t* Kh = cur.K; const bf16_t* Vh = cur.V;
#define RESC(a) do { if (__any((a) < 1.f)) { if (hi == 0) al_l[r32] = (a); asm volatile("s_waitcnt lgkmcnt(0)" ::: "memory");              \
                     _Pragma("unroll") for (int d_ = 0; d_ < 4; ++d_) _Pragma("unroll") for (int r = 0; r < 16; ++r) o[d_][r] *= al_l[crow(r, hi)]; } } while (0)
#define KBASE(t) ((t) * KVBLK)
#define MASKT(P0_, P1_, t) do { const int kb_ = KBASE(t); if (kb_ + KVBLK - 1 > qlo) mask_tile(P0_, P1_, qm - kb_); } while (0)
#define SEAM_K0() do { VMWN(4); SWRITE_HK(0); SBAR(); } while (0)
    f32x16 pA0, pA1, pB0, pB1; float mnA, mnB, alA, alB; bf16x8 pa0, pa1, pa2, pa3;
    SWRITE_HV(0); SBAR();
    if (NT > 1) SLOAD_H(Kh, Vh, KBASE(1));
    SBAR(); qkt<0>(pA0, pA1, K_lds, r32, hi, S.qr);
    MASKT(pA0, pA1, 0); partialSM(pA0, pA1, m_reg, mnA, alA);
    if (NT > 1) { VMW(); SWRITE_H(1); }
    __syncthreads();
#define HALF_STEP(PX0, PX1, mnX, alX, PY0, PY1, alY, t, KB, VB, SB) do {                                                      \
        SBAR(); qkt<KB>(PX0, PX1, K_lds, r32, hi, S.qr);                                                                      \
        finishSM(PY0, PY1, alY, l_reg, pa0, pa1, pa2, pa3); SBAR();                                                           \
        if ((t) + 1 < NT) { SLOAD_H(Kh, Vh, KBASE((t) + 1)); SBAR(); }                                                        \
        pv_tile<VB>(o, vb0, pa0, pa1, pa2, pa3); MASKT(PX0, PX1, (t)); partialSM(PX0, PX1, m_reg, mnX, alX);                  \
        __syncthreads();                                                                                                      \
        if ((t) + 1 < NT) { VMW(); SWRITE_H(SB); }                                                                            \
        RESC(alX); __syncthreads(); } while (0)
    for (int t = 1; t + 1 < NT; t += 2) {
        HALF_STEP(pB0, pB1, mnB, alB, pA0, pA1, alA, t, 1, 0, 0);
        HALF_STEP(pA0, pA1, mnA, alA, pB0, pB1, alB, t + 1, 0, 1, 1);
    }
    const bool even = (NT & 1) == 0;
    if (even) { SBAR(); qkt<1>(pB0, pB1, K_lds, r32, hi, S.qr); SBAR(); }
    SLOAD_H(nxt.K, nxt.V, 0); SBAR();
#pragma unroll
    for (int d0 = 0; d0 < 4; ++d0) S.qr[d0] = load8(nxt.Q + (size_t)(wid * QBLK + r32) * PQ + d0 * 16 + hi * 8);
    SBAR();
    finishSM(pA0, pA1, alA, l_reg, pa0, pa1, pa2, pa3); SBAR();
    pv_tile<0>(o, vb0, pa0, pa1, pa2, pa3);
    if (even) { MASKT(pB0, pB1, NT - 1); partialSM(pB0, pB1, m_reg, mnB, alB); __syncthreads(); RESC(alB);
        finishSM(pB0, pB1, alB, l_reg, pa0, pa1, pa2, pa3); SBAR(); pv_tile<1>(o, vb0, pa0, pa1, pa2, pa3); }
    SBAR(); SEAM_K0();
    if (hi == 0) li_l[r32] = l_reg; asm volatile("s_waitcnt lgkmcnt(0)" ::: "memory");
    float rli[16];
#pragma unroll
    for (int r = 0; r < 16; ++r) rli[r] = __builtin_amdgcn_rcpf(li_l[crow(r, hi)]);
    bf16_t* Ow = cur.O + (size_t)(wid * QBLK) * PO;
#pragma unroll
    for (int r = 0; r < 16; ++r) { const int orow = crow(r, hi);
#pragma unroll
        for (int d0 = 0; d0 < 4; ++d0) { const float v = o[d0][r] * rli[r];
            const float vn = __shfl_xor(v, 1);
            if ((r32 & 1) == 0) *(unsigned*)(Ow + (size_t)orow * PO + d0 * 32 + r32) = cvtpk(v, vn); } }
    __syncthreads();
#undef RESC
#undef KBASE
#undef MASKT
#undef SEAM_K0
#undef HALF_STEP
}
#undef VMW
#undef VMWN
#undef SLOAD_H
#undef SWRITE_HK
#undef SWRITE_HV
#undef SWRITE_H
__device__ __forceinline__ BlockRef ref_of(int s, int v, int G, const bf16_t* Q, const bf16_t* K, const bf16_t* V, bf16_t* O) {
    const int L = v + (s >> 1) * G; const int b = (L >> 5) & 7, idx = (L & 31) + 32 * (L >> 8), vh = idx >> 4, y = idx & 15;
    const int qb = (s & 1) ? (NQB - 1 - y) : y; const int h = vh >> 1, m = vh & 1;
    const size_t rb = (size_t)b * SEQ;
    BlockRef r;
    r.Q = Q + (rb + (size_t)qb * QB) * PQ + h * 128 + m * 64; r.K = K + rb * PQ + h * 128 + m * 64; r.V = V + rb * PQ + h * 128;
    r.O = O + (rb + (size_t)qb * QB) * PO + h * 256 + m * 128; r.P0 = qb * QB; return r;
}
__device__ __forceinline__ void attn_phase(char* lds, const bf16_t* Q, const bf16_t* K, const bf16_t* V, bf16_t* O, int v, int G) {
    constexpr int TOTAL = NB * 8 * (NQB / 2);
    if (v >= TOTAL) return;
    const int nitems = (TOTAL - v + G - 1) / G, ns = 2 * nitems;
    BlockRef cur = ref_of(0, v, G, Q, K, V, O);
    Seam S;
    prime(cur, lds, S);
    for (int s = 0; s < ns; ++s) {
        const BlockRef nxt = (s + 1 < ns) ? ref_of(s + 1, v, G, Q, K, V, O) : cur;
        block(cur, nxt, lds, S);
        cur = nxt;
    }
}
#undef KSWZ
#undef SBAR
}
struct Frame {
    LAS unsigned char* lds;
    volatile LAS unsigned* MISC;
    gu32* ctl;
    int tid, lane, wave, vcu, G;
    float* out; unsigned char* ws;
};
enum { I_X = 0, I_C, I_WADA, I_BADA, I_WIN, I_LQ1, I_LK1, I_LQ2, I_LK2, I_SUBLN, I_SGG, I_SGB, I_WSP, I_BSP, I_WOUT, I_LN1G, I_LN1B, I_WGRP, I_BGRP, I_WRT, I_BRT, I_WGATE, I_WUP, I_WDOWN, I_LN2G, I_LN2B };

__device__ __forceinline__ const float* in_ptr(int i) {
    const __attribute__((address_space(4))) char* kp = (const __attribute__((address_space(4))) char*)__builtin_amdgcn_kernarg_segment_ptr();
    asm volatile("" : "+s"(kp));
    return *(const float* const __attribute__((address_space(4)))*)(kp + 8 * i);
}
#define INP(i) in_ptr(i)
#define OPAQUE_IDS(F) do { asm volatile("" : "+v"(F.tid)); F.lane = F.tid & 63; F.wave = __builtin_amdgcn_readfirstlane(F.tid >> 6); } while (0)
__constant__ float INVF[32] = {1.000000000e+00f, 7.498942018e-01f, 5.623413324e-01f, 4.216965139e-01f, 3.162277639e-01f, 2.371373922e-01f, 1.778279394e-01f, 1.333521456e-01f, 1.000000015e-01f, 7.498941571e-02f, 5.623412877e-02f, 4.216964915e-02f, 3.162277862e-02f, 2.371373586e-02f, 1.778279431e-02f, 1.333521493e-02f, 9.999999776e-03f, 7.498942316e-03f, 5.623413250e-03f, 4.216964822e-03f, 3.162277862e-03f, 2.371373819e-03f, 1.778279431e-03f, 1.333521446e-03f, 1.000000047e-03f, 7.498941850e-04f, 5.623413017e-04f, 4.216965463e-04f, 3.162277862e-04f, 2.371373848e-04f, 1.778279402e-04f, 1.333521504e-04f};
__device__ __forceinline__ void sincos_d(double x, double& s, double& c) {
    const double k = __builtin_rint(x * 0.63661977236758134308); const int q = (int)k & 3;
    double r = __builtin_fma(-k, 1.57079632679489655800e+00, x); r = __builtin_fma(-k, 6.12323399573676603587e-17, r);
    const double r2 = r * r;
    double sp = -1.0 / 1307674368000.0; sp = sp * r2 + 1.0 / 6227020800.0; sp = sp * r2 - 1.0 / 39916800.0; sp = sp * r2 + 1.0 / 362880.0; sp = sp * r2 - 1.0 / 5040.0; sp = sp * r2 + 1.0 / 120.0; sp = sp * r2 - 1.0 / 6.0; sp = sp * r2 * r + r;
    double cp = 1.0 / 20922789888000.0; cp = cp * r2 - 1.0 / 87178291200.0; cp = cp * r2 + 1.0 / 479001600.0; cp = cp * r2 - 1.0 / 3628800.0; cp = cp * r2 + 1.0 / 40320.0; cp = cp * r2 - 1.0 / 720.0; cp = cp * r2 + 1.0 / 24.0; cp = cp * r2 - 0.5; cp = cp * r2 + 1.0;
    s = (q == 0) ? sp : (q == 1) ? cp : (q == 2) ? -sp : -cp;
    c = (q == 0) ? cp : (q == 1) ? -sp : (q == 2) ? -cp : sp;
}
__device__ __forceinline__ int c5_of_s5(int s) { return ((s & 0x18) >> 1) | ((s & 4) << 2) | (s & 3); }
__device__ __forceinline__ int map_store(int n) { return (n & ~31) | c5_of_s5(n & 31); }
__device__ __forceinline__ int map_inproj(int n) { if (n < 1024) { const int b4 = (n >> 4) & 1, b5 = (n >> 5) & 1; return (n & ~0x30) | (b4 << 5) | (b5 << 4); } return map_store(n); }
__device__ __forceinline__ int map_gateup(int hh, int up) { return 256 * (hh >> 7) + 128 * ((hh >> 2) & 1) + 32 * ((hh >> 5) & 3) + 16 * up + 4 * ((hh >> 3) & 3) + (hh & 3); }

template <int MAP>
__device__ __forceinline__ void p0_transpose_item(const float* W, int K, int N, bf16_t* WT, LAS float* scr, int item, int lane) {
    const int nblk = N / 32, kb = item / nblk, nb = item % nblk, k0 = 64 * kb, n0 = 32 * nb;
#pragma unroll 8
    for (int i = 0; i < 32; ++i) { const int kk = 2 * i + (lane >> 5); scr[kk * 33 + (lane & 31)] = W[(size_t)(k0 + kk) * N + n0 + (lane & 31)]; }
    LDS_WAIT(); asm volatile("" ::: "memory");
    const int c = lane & 7;
#pragma unroll
    for (int j = 0; j < 4; ++j) { const int n = (lane >> 3) + 8 * j; const LAS float* s = scr + (8 * c) * 33 + n;
        u32x4 o; o.x = cvtpk(s[0 * 33], s[1 * 33]); o.y = cvtpk(s[2 * 33], s[3 * 33]); o.z = cvtpk(s[4 * 33], s[5 * 33]); o.w = cvtpk(s[6 * 33], s[7 * 33]);
        const int src = n0 + n;
        const int dst = (MAP == 0) ? src : (MAP == 1) ? map_inproj(src) : (MAP == 2) ? map_store(src) : (MAP == 3) ? map_gateup(src, 0) : map_gateup(src, 1);
        *(GAS u32x4*)(WT + (size_t)dst * K + k0 + 8 * c) = o; }
    LDS_WAIT(); asm volatile("" ::: "memory");
}
__device__ __forceinline__ void p0_mod_item(Frame& F, int item) {
    const int l = item / 24, cg = item % 24;
    LAS float* sil = (LAS float*)F.lds;
    LAS float* red = (LAS float*)(F.lds + 32768);
    for (int i = F.tid; i < NB * DM; i += NWAVES * 64) { const float cv = INP(I_C)[i]; sil[i] = cv / (1.0f + __expf(-cv)); }
    __syncthreads();
    const float* W = INP(I_WADA) + (size_t)l * DM * 6144 + cg * 256 + 4 * F.lane;
    f32x4 acc[NB];
#pragma unroll
    for (int b = 0; b < NB; ++b) acc[b] = (f32x4){0.f, 0.f, 0.f, 0.f};
    const int k0 = F.wave * 128;
#pragma unroll 4
    for (int k = 0; k < 128; ++k) { const f32x4 wv = *(const f32x4*)(W + (size_t)(k0 + k) * 6144);
#pragma unroll
        for (int b = 0; b < NB; ++b) acc[b] += wv * sil[b * DM + k0 + k]; }
#pragma unroll
    for (int b = 0; b < NB; ++b) *(LAS f32x4*)(red + (F.wave * NB + b) * 256 + 4 * F.lane) = acc[b];
    __syncthreads();
    float* mod = (float*)(F.ws + WS_MOD) + (size_t)l * NB * 6144;
    for (int o = F.tid; o < NB * 256; o += NWAVES * 64) { const int b = o >> 8, n = o & 255; float s = INP(I_BADA)[l * 6144 + cg * 256 + n];
#pragma unroll
        for (int w = 0; w < NWAVES; ++w) s += red[(w * NB + b) * 256 + n];
        mod[b * 6144 + cg * 256 + n] = s; }
    __syncthreads();
}
__device__ __forceinline__ void p0_prologue(Frame& F) {
    OPAQUE_IDS(F);
    if (blockIdx.x < 48) p0_mod_item(F, (int)blockIdx.x);
    const int gt = (int)blockIdx.x * NWAVES * 64 + F.tid, NGT = F.G * NWAVES * 64;
    { float* cosT = (float*)(F.ws + WS_COS); float* sinT = (float*)(F.ws + WS_SIN);
      for (int i = gt; i < SEQ * 32; i += NGT) { const int pos = i >> 5, f = i & 31;
          const float ang = (float)pos * INVF[f]; double sv, cv; sincos_d((double)ang, sv, cv);
          cosT[i] = (float)cv; sinT[i] = (float)sv; } }
    if (blockIdx.x == 48 && F.tid < DEPTH) { const int l = F.tid; float s1 = 0.f, s2 = 0.f; const float* q1 = INP(I_LQ1); const float* k1 = INP(I_LK1); const float* q2 = INP(I_LQ2); const float* k2 = INP(I_LK2);
        for (int i = 0; i < 64; ++i) { s1 += q1[l * 64 + i] * k1[l * 64 + i]; s2 += q2[l * 64 + i] * k2[l * 64 + i]; }
        const float lam_init = 0.8f - 0.6f * expf(-0.3f * (float)l);
        float* sc = (float*)(F.ws + WS_SCAL) + l * 4; sc[0] = expf(s1) - expf(s2) + lam_init; sc[1] = 1.0f - lam_init; sc[2] = 0.f; sc[3] = 0.f; }
    { bf16_t* wsp = (bf16_t*)(F.ws + WS_WSP);
      for (int i = gt; i < DEPTH * 4 * 128 * 128 / 2; i += NGT) { const int e0 = 2 * i, s = e0 & 127, t = (e0 >> 7) & 127;
          const float a = (s <= t) ? INP(I_WSP)[e0] : 0.f, b = (s + 1 <= t) ? INP(I_WSP)[e0 + 1] : 0.f; ((unsigned*)wsp)[i] = cvtpk(a, b); } }
    { const int gw = (int)blockIdx.x * NWAVES + F.wave, NGW = F.G * NWAVES;
      for (int it = gw; it < DEPTH * 96; it += NGW) { const int l = it / 96, f = it % 96, blk = f % 3, gs = f / 3, g = gs >> 2, s = gs & 3;
          const int i = F.lane & 15, q = F.lane >> 4, kb = 128 * g + 32 * q + 8 * s; float v[8];
#pragma unroll
          for (int j = 0; j < 8; ++j) { const int k = kb + j; float x = 0.f;
              if (blk < 2) { const int Gp = 2 * blk + (i >> 3), e = i & 7; x = INP(I_WRT)[(((size_t)l * 4 + Gp) * DM + k) * 8 + e]; }
              else if (i < 4) x = INP(I_WGRP)[((size_t)l * DM + k) * 4 + i];
              v[j] = x; }
          u32x4 o; o.x = cvtpk(v[0], v[1]); o.y = cvtpk(v[2], v[3]); o.z = cvtpk(v[4], v[5]); o.w = cvtpk(v[6], v[7]);
          *((u32x4*)(F.ws + WS_RIMG) + (size_t)it * 64 + F.lane) = o; } }
    LAS float* scr = (LAS float*)(F.lds + F.wave * 16384);
    const int gw = (int)blockIdx.x * NWAVES + F.wave, NGW = F.G * NWAVES;
    constexpr int I_IN = 16 * 80, I_OUT = 16 * 32, I_G = 32 * 256, I_D = 32 * 256, PER_L = I_IN + I_OUT + 2 * I_G + I_D;
    for (int it = gw; it < DEPTH * PER_L; it += NGW) {
        const int l = it / PER_L; int r = it % PER_L;
        if (r < I_IN) { p0_transpose_item<1>(INP(I_WIN) + (size_t)l * DM * INC, DM, INC, (bf16_t*)(F.ws + WS_WIN) + (size_t)l * INC * DM, scr, r, F.lane); continue; } r -= I_IN;
        if (r < I_OUT) { p0_transpose_item<0>(INP(I_WOUT) + (size_t)l * DM * DM, DM, DM, (bf16_t*)(F.ws + WS_WOUT) + (size_t)l * DM * DM, scr, r, F.lane); continue; } r -= I_OUT;
        if (r < I_G) { const int e = r >> 8; p0_transpose_item<3>(INP(I_WGATE) + ((size_t)l * NEXP + e) * DM * DEXP, DM, DEXP, (bf16_t*)(F.ws + WS_WGU) + ((size_t)l * NEXP + e) * 1024 * DM, scr, r & 255, F.lane); continue; } r -= I_G;
        if (r < I_G) { const int e = r >> 8; p0_transpose_item<4>(INP(I_WUP) + ((size_t)l * NEXP + e) * DM * DEXP, DM, DEXP, (bf16_t*)(F.ws + WS_WGU) + ((size_t)l * NEXP + e) * 1024 * DM, scr, r & 255, F.lane); continue; } r -= I_G;
        { const int e = r >> 8; p0_transpose_item<2>(INP(I_WDOWN) + ((size_t)l * NEXP + e) * DEXP * DM, DEXP, DM, (bf16_t*)(F.ws + WS_WD) + ((size_t)l * NEXP + e) * DM * DEXP, scr, r & 255, F.lane); }
    }
}
__device__ __forceinline__ void store_bf16_row(bf16_t* orow, const f32x4 (&v)[4], int lane) {
    GAS u32x2* o8 = (GAS u32x2*)orow + lane;
#pragma unroll
    for (int j = 0; j < 4; ++j) { u32x2 w; w.x = cvtpk(v[j].x, v[j].y); w.y = cvtpk(v[j].z, v[j].w); o8[64 * j] = w; }
}
__device__ __forceinline__ void p1_htransform(Frame& F) {
    OPAQUE_IDS(F);
    const int gw = F.vcu * NWAVES + F.wave, NGW = F.G * NWAVES;
    const float* mod = (const float*)(F.ws + WS_MOD);
    for (int m = gw; m < MTOK; m += NGW) { const int b = m >> 13; const GAS f32x4* xr = (const GAS f32x4*)(INP(I_X) + (size_t)m * DM) + F.lane;
        const GAS f32x4* sh = (const GAS f32x4*)(mod + b * 6144) + F.lane; const GAS f32x4* sc = (const GAS f32x4*)(mod + b * 6144 + 1024) + F.lane;
        f32x4 v[4];
#pragma unroll
        for (int j = 0; j < 4; ++j) v[j] = xr[64 * j] * (sc[64 * j] + 1.0f) + sh[64 * j];
        store_bf16_row((bf16_t*)(F.ws + WS_HB) + (size_t)m * DM, v, F.lane); }
}
__device__ __forceinline__ void ln_row(f32x4 (&v)[4], const float* g, const float* bta, int lane) {
    float s = 0.f;
#pragma unroll
    for (int j = 0; j < 4; ++j) s += (v[j].x + v[j].y) + (v[j].z + v[j].w);
    const float mean = wave_sum(s) * (1.f / DM); float s2 = 0.f;
#pragma unroll
    for (int j = 0; j < 4; ++j) { v[j] = v[j] - mean; s2 += (v[j].x * v[j].x + v[j].y * v[j].y) + (v[j].z * v[j].z + v[j].w * v[j].w); }
    const float rstd = 1.f / sqrtf(wave_sum(s2) * (1.f / DM) + LN_EPS);
#pragma unroll
    for (int j = 0; j < 4; ++j) { const f32x4 gg = *((const f32x4*)g + lane + 64 * j), bb = *((const f32x4*)bta + lane + 64 * j); v[j] = v[j] * rstd * gg + bb; }
}
__device__ __forceinline__ void p_ln1(Frame& F, int l) {
    OPAQUE_IDS(F);
    const int gw = F.vcu * NWAVES + F.wave, NGW = F.G * NWAVES;
    const float* mod = (const float*)(F.ws + WS_MOD) + (size_t)l * NB * 6144;
    for (int m = gw; m < MTOK; m += NGW) { const int b = m >> 13; GAS f32x4* xr = (GAS f32x4*)(F.out + (size_t)m * DM) + F.lane;
        f32x4 v[4];
#pragma unroll
        for (int j = 0; j < 4; ++j) v[j] = xr[64 * j];
        ln_row(v, INP(I_LN1G) + l * DM, INP(I_LN1B) + l * DM, F.lane);
#pragma unroll
        for (int j = 0; j < 4; ++j) xr[64 * j] = v[j];
        const GAS f32x4* sh = (const GAS f32x4*)(mod + b * 6144 + 3072) + F.lane; const GAS f32x4* sc = (const GAS f32x4*)(mod + b * 6144 + 4096) + F.lane;
#pragma unroll
        for (int j = 0; j < 4; ++j) v[j] = v[j] * (sc[64 * j] + 1.0f) + sh[64 * j];
        store_bf16_row((bf16_t*)(F.ws + WS_HB) + (size_t)m * DM, v, F.lane); }
}
__device__ __forceinline__ void p_ln2(Frame& F, int l) {
    OPAQUE_IDS(F);
    const int gw = F.vcu * NWAVES + F.wave, NGW = F.G * NWAVES;
    const float* mod = (const float*)(F.ws + WS_MOD) + (size_t)l * NB * 6144;
    const bf16_t* y2 = (const bf16_t*)(F.ws + WS_Y2);
    for (int m = gw; m < MTOK; m += NGW) { const int b = m >> 13; GAS f32x4* xr = (GAS f32x4*)(F.out + (size_t)m * DM) + F.lane;
        const GAS u32x2* ya = (const GAS u32x2*)(y2 + (size_t)m * 2 * DM) + F.lane; const GAS u32x2* yb = ya + 256;
        const GAS f32x4* gt = (const GAS f32x4*)(mod + b * 6144 + 5120) + F.lane;
        f32x4 v[4];
#pragma unroll
        for (int j = 0; j < 4; ++j) { const u32x2 a = ya[64 * j], c = yb[64 * j];
            const f32x4 f = (f32x4){bflo(a.x) + bflo(c.x), bfhi(a.x) + bfhi(c.x), bflo(a.y) + bflo(c.y), bfhi(a.y) + bfhi(c.y)};
            v[j] = xr[64 * j] * ALPHA + (gt[64 * j] + 1.0f) * f; }
        ln_row(v, INP(I_LN2G) + l * DM, INP(I_LN2B) + l * DM, F.lane);
#pragma unroll
        for (int j = 0; j < 4; ++j) xr[64 * j] = v[j];
        if (l + 1 < DEPTH) { const float* mod1 = mod + NB * 6144;
            const GAS f32x4* sh = (const GAS f32x4*)(mod1 + b * 6144) + F.lane; const GAS f32x4* sc = (const GAS f32x4*)(mod1 + b * 6144 + 1024) + F.lane;
#pragma unroll
            for (int j = 0; j < 4; ++j) v[j] = v[j] * (sc[64 * j] + 1.0f) + sh[64 * j];
            store_bf16_row((bf16_t*)(F.ws + WS_HB) + (size_t)m * DM, v, F.lane); } }
}
__device__ __forceinline__ void p_diffnorm(Frame& F, int l) {
    OPAQUE_IDS(F);
    const int gw = F.vcu * NWAVES + F.wave, NGW = F.G * NWAVES;
    const float lam = __uint_as_float(__hip_atomic_load((const unsigned*)(F.ws + WS_SCAL) + l * 4, RLX_AGENT)), oml = __uint_as_float(__hip_atomic_load((const unsigned*)(F.ws + WS_SCAL) + l * 4 + 1, RLX_AGENT));
    const bf16_t* o12 = (const bf16_t*)(F.ws + WS_O12); bf16_t* mix = (bf16_t*)(F.ws + WS_MIXA);
    const int h = F.lane >> 4, j = F.lane & 15;
    const f32x4 g0 = *(const f32x4*)(INP(I_SUBLN) + l * 128 + 8 * j) * oml, g1 = *(const f32x4*)(INP(I_SUBLN) + l * 128 + 8 * j + 4) * oml;
    for (int m = gw; m < MTOK; m += NGW) {
        const u32x4 a = *(const GAS u32x4*)(o12 + (size_t)m * 1024 + h * 256 + 8 * j), c = *(const GAS u32x4*)(o12 + (size_t)m * 1024 + h * 256 + 128 + 8 * j);
        f32x4 d0 = (f32x4){bflo(a.x) - lam * bflo(c.x), bfhi(a.x) - lam * bfhi(c.x), bflo(a.y) - lam * bflo(c.y), bfhi(a.y) - lam * bfhi(c.y)};
        f32x4 d1 = (f32x4){bflo(a.z) - lam * bflo(c.z), bfhi(a.z) - lam * bfhi(c.z), bflo(a.w) - lam * bflo(c.w), bfhi(a.w) - lam * bfhi(c.w)};
        float ss = (d0.x * d0.x + d0.y * d0.y) + (d0.z * d0.z + d0.w * d0.w) + (d1.x * d1.x + d1.y * d1.y) + (d1.z * d1.z + d1.w * d1.w);
        ss += __shfl_xor(ss, 1); ss += __shfl_xor(ss, 2); ss += __shfl_xor(ss, 4); ss += __shfl_xor(ss, 8);
        const float rs = 1.f / sqrtf(ss * (1.f / 128.f) + LN_EPS);
        d0 = d0 * rs * g0; d1 = d1 * rs * g1;
        *(GAS u32x4*)(mix + (size_t)m * 1024 + h * 128 + 8 * j) = pg8::pack8(d0, d1); }
}
__device__ __forceinline__ void p_sg(Frame& F, int l) {
    OPAQUE_IDS(F);
    constexpr int ZS = 136;
    LAS bf16_t* zT = (LAS bf16_t*)F.lds;
    const bf16_t* Zb = (const bf16_t*)(F.ws + WS_Q + 4 * WS_QSTRIDE); const bf16_t* Ub = (const bf16_t*)(F.ws + WS_Q + 3 * WS_QSTRIDE);
    bf16_t* mix = (bf16_t*)(F.ws + WS_MIXA);
    const int r32 = F.lane & 31, hi = F.lane >> 5;
    for (int u = F.vcu; u < (MTOK / 128) * 4; u += F.G) { const int n = u >> 2, g = u & 3;
        { const int s = F.tid >> 2, qd = F.tid & 3; const bf16_t* zp = Zb + (size_t)(n * 128 + s) * 512 + g * 128 + qd * 32;
          u32x4 raw[4]; float x[32];
#pragma unroll
          for (int i = 0; i < 4; ++i) raw[i] = *(const GAS u32x4*)(zp + 8 * i);
#pragma unroll
          for (int i = 0; i < 4; ++i) { x[8 * i + 0] = bflo(raw[i].x); x[8 * i + 1] = bfhi(raw[i].x); x[8 * i + 2] = bflo(raw[i].y); x[8 * i + 3] = bfhi(raw[i].y);
              x[8 * i + 4] = bflo(raw[i].z); x[8 * i + 5] = bfhi(raw[i].z); x[8 * i + 6] = bflo(raw[i].w); x[8 * i + 7] = bfhi(raw[i].w); }
          float sm = 0.f;
#pragma unroll
          for (int i = 0; i < 32; ++i) sm += x[i];
          sm += __shfl_xor(sm, 1); sm += __shfl_xor(sm, 2); const float mean = sm * (1.f / 128.f); float sq = 0.f;
#pragma unroll
          for (int i = 0; i < 32; ++i) { x[i] -= mean; sq += x[i] * x[i]; }
          sq += __shfl_xor(sq, 1); sq += __shfl_xor(sq, 2); const float rstd = 1.f / sqrtf(sq * (1.f / 128.f) + LN_EPS);
          const float* lg = INP(I_SGG) + (l * 4 + g) * 128 + qd * 32; const float* lb = INP(I_SGB) + (l * 4 + g) * 128 + qd * 32;
#pragma unroll
          for (int i = 0; i < 32; ++i) { const float zn = x[i] * rstd * lg[i] + lb[i]; zT[(qd * 32 + i) * ZS + s] = (bf16_t)(cvtpk(zn, 0.f) & 0xffffu); } }
        __syncthreads();
        { const int cb = F.wave & 3, tb0 = 2 * (F.wave >> 2);
          const bf16_t* Wg = (const bf16_t*)(F.ws + WS_WSP) + (size_t)(l * 4 + g) * 128 * 128;
          f32x16 acc[2]; acc[0] = f32x16{}; acc[1] = f32x16{};
#pragma unroll
          for (int ks = 0; ks < 8; ++ks) { const bf16x8 a = *(const LAS bf16x8*)(zT + (cb * 32 + r32) * ZS + ks * 16 + hi * 8);
#pragma unroll
              for (int tb = 0; tb < 2; ++tb) { if (ks <= 2 * (tb0 + tb) + 1) { const bf16x8 bw = *(const GAS bf16x8*)(Wg + (size_t)((tb0 + tb) * 32 + r32) * 128 + ks * 16 + hi * 8);
                  acc[tb] = __builtin_amdgcn_mfma_f32_32x32x16_bf16(a, bw, acc[tb], 0, 0, 0); } } }
#pragma unroll
          for (int tb = 0; tb < 2; ++tb) { const int t = (tb0 + tb) * 32 + r32; const float bs = INP(I_BSP)[(l * 4 + g) * 128 + t];
              const size_t row = (size_t)(n * 128 + t);
#pragma unroll
              for (int r4 = 0; r4 < 4; ++r4) { const int c = cb * 32 + 8 * r4 + 4 * hi;
                  const u32x2 zu = *(const GAS u32x2*)(Ub + row * 512 + g * 128 + c);
                  u32x2 o; o.x = cvtpk(bflo(zu.x) * (acc[tb][4 * r4 + 0] + bs), bfhi(zu.x) * (acc[tb][4 * r4 + 1] + bs));
                  o.y = cvtpk(bflo(zu.y) * (acc[tb][4 * r4 + 2] + bs), bfhi(zu.y) * (acc[tb][4 * r4 + 3] + bs));
                  *(GAS u32x2*)(mix + row * 1024 + 512 + g * 128 + c) = o; } } }
        __syncthreads();
    }
}
__device__ __forceinline__ void p_router(Frame& F, int l) {
    OPAQUE_IDS(F);
    constexpr int LS = 41;
    LAS float* lg = (LAS float*)F.lds + F.wave * (32 * LS);
    LAS int* hist = (LAS int*)(F.lds + 65536); LAS int* base = hist + 32;
    const bf16_t* hb = (const bf16_t*)(F.ws + WS_HB);
    const u32x4* img = (const u32x4*)(F.ws + WS_RIMG) + (size_t)l * 96 * 64;
    unsigned* lst = (unsigned*)(F.ws + WS_LST); float* cwp = (float*)(F.ws + WS_CW);
    const int j = F.lane & 15, q = F.lane >> 4;
    for (int tile = F.vcu; tile < MTOK / 256; tile += F.G) {
        if (F.tid < 32) hist[F.tid] = 0;
        const int tok0 = tile * 256 + F.wave * 32;
        f32x4 acc[3][2];
#pragma unroll
        for (int b = 0; b < 3; ++b)
#pragma unroll
            for (int c = 0; c < 2; ++c) acc[b][c] = (f32x4){0.f, 0.f, 0.f, 0.f};
#pragma unroll 2
        for (int g = 0; g < 8; ++g) { bf16x8 tf[2][4];
#pragma unroll
            for (int cb = 0; cb < 2; ++cb) { const bf16_t* p = hb + (size_t)(tok0 + 16 * cb + j) * DM + 128 * g + 32 * q;
#pragma unroll
                for (int s = 0; s < 4; ++s) tf[cb][s] = *(const GAS bf16x8*)(p + 8 * s); }
#pragma unroll
            for (int s = 0; s < 4; ++s)
#pragma unroll
                for (int blk = 0; blk < 3; ++blk) { const u32x4 wv = img[((g * 4 + s) * 3 + blk) * 64 + F.lane]; const bf16x8 wf = __builtin_bit_cast(bf16x8, wv);
#pragma unroll
                    for (int cb = 0; cb < 2; ++cb) acc[blk][cb] = __builtin_amdgcn_mfma_f32_16x16x32_bf16(wf, tf[cb][s], acc[blk][cb], 0, 0, 0); } }
#pragma unroll
        for (int cb = 0; cb < 2; ++cb) {
#pragma unroll
            for (int r = 0; r < 4; ++r) { lg[(16 * cb + j) * LS + 4 * q + r] = acc[0][cb][r]; lg[(16 * cb + j) * LS + 16 + 4 * q + r] = acc[1][cb][r]; if (q == 0) lg[(16 * cb + j) * LS + 32 + r] = acc[2][cb][r]; } }
        __syncthreads();
        int E1 = 0, E2 = 0, r1 = 0, r2 = 0; float c1 = 0.f, c2 = 0.f;
        if (F.lane < 32) { const LAS float* my = lg + F.lane * LS;
            float gl[4];
#pragma unroll
            for (int i = 0; i < 4; ++i) gl[i] = my[32 + i] + INP(I_BGRP)[l * 4 + i];
            float best = gl[0]; int gi = 0;
#pragma unroll
            for (int i = 1; i < 4; ++i) if (gl[i] > best) { best = gl[i]; gi = i; }
            float den = 0.f;
#pragma unroll
            for (int i = 0; i < 4; ++i) den += __expf(gl[i] - best);
            const float gp = 1.0f / den;
            float sel[8];
#pragma unroll
            for (int e = 0; e < 8; ++e) sel[e] = my[gi * 8 + e] + INP(I_BRT)[(l * 4 + gi) * 8 + e];
            float v1 = sel[0]; int i1 = 0;
#pragma unroll
            for (int e = 1; e < 8; ++e) if (sel[e] > v1) { v1 = sel[e]; i1 = e; }
            float v2 = -__builtin_inff(); int i2 = 0;
#pragma unroll
            for (int e = 0; e < 8; ++e) if (e != i1 && sel[e] > v2) { v2 = sel[e]; i2 = e; }
            const float w1 = 1.0f / (1.0f + __expf(v2 - v1)), w2 = 1.0f - w1;
            c1 = gp * w1; c2 = gp * w2; E1 = gi * 8 + i1; E2 = gi * 8 + i2;
            r1 = __hip_atomic_fetch_add(hist + E1, 1, __ATOMIC_RELAXED, __HIP_MEMORY_SCOPE_WORKGROUP);
            r2 = __hip_atomic_fetch_add(hist + E2, 1, __ATOMIC_RELAXED, __HIP_MEMORY_SCOPE_WORKGROUP); }
        __syncthreads();
        if (F.tid < 32) base[F.tid] = (int)__hip_atomic_fetch_add((unsigned*)(F.ctl + CW_CNT + l * 32 + F.tid), (unsigned)hist[F.tid], RLX_AGENT);
        __syncthreads();
        if (F.lane < 32) { const unsigned tok = (unsigned)(tok0 + F.lane);
            const size_t p1 = (size_t)E1 * LCAP + base[E1] + r1, p2 = (size_t)E2 * LCAP + base[E2] + r2;
            lst[p1] = tok * 2u; cwp[p1] = c1; lst[p2] = tok * 2u + 1u; cwp[p2] = c2; }
        __syncthreads();
    }
}
__device__ __forceinline__ int expert_setup(Frame& F, int l, bool fill_idx) {
    OPAQUE_IDS(F);
    LAS int* ppre = (LAS int*)(F.lds + PPRE_OFF); LAS int* cnt = ppre + 40;
    if (F.tid < 32) cnt[F.tid] = (int)__hip_atomic_load((unsigned*)(F.ctl + CW_CNT + l * 32 + F.tid), RLX_AGENT);
    __syncthreads();
    if (F.tid == 0) { int s = 0; for (int e = 0; e < NEXP; ++e) { ppre[e] = s; s += (cnt[e] + 255) >> 8; } ppre[NEXP] = s; }
    __syncthreads();
    const int TP = ppre[NEXP];
    if (fill_idx) { LAS unsigned* idx = (LAS unsigned*)(F.lds + IDX_OFF); const unsigned* lst = (const unsigned*)(F.ws + WS_LST);
        for (int i = 0; i < IDX_SLOTS; ++i) { const int L = i * F.G + (int)blockIdx.x; if (L >= 4 * TP) break;
            const int p = L >> 2; int e = 0; while (e < NEXP - 1 && ppre[e + 1] <= p) ++e;
            const int row0 = (p - ppre[e]) * 256, rem = cnt[e] - row0;
            if (F.tid < 256) idx[i * 256 + F.tid] = (F.tid < rem) ? (lst[(size_t)e * LCAP + row0 + F.tid] >> 1) : 0u; }
        __syncthreads(); }
    return TP;
}
#define XB_TMO      128
#define XB_XCNT(j)  (256  + 64 * (j))
#define XB_XSUB(j)  (1280 + 64 * (j))
#define XB_XGEN(j)  (2304 + 64 * (j))
#define XB_TOP      3328
#define XB_TOPGEN   3392
#define XCD_BAR_WORDS 3456
#define XB_SPIN_CAP (1u << 18)

__device__ __forceinline__ unsigned xb_ld(unsigned* p)              { return __hip_atomic_load(p, __ATOMIC_RELAXED, __HIP_MEMORY_SCOPE_AGENT); }
__device__ __forceinline__ unsigned xb_add(unsigned* p, unsigned v) { return __hip_atomic_fetch_add(p, v, __ATOMIC_RELAXED, __HIP_MEMORY_SCOPE_AGENT); }
__device__ __forceinline__ unsigned xb_xcc_id() { return (unsigned)__builtin_amdgcn_s_getreg((3 << 11) | 20) & 0xFu; }
#define XB_SPIN(cond, bar) do { unsigned _sp = 0; while (cond) { __builtin_amdgcn_s_sleep(1); \
    if ((++_sp & 255u) == 0u) { if (xb_ld(&(bar)[XB_TMO])) break; if (_sp > XB_SPIN_CAP) { atomicAdd(&(bar)[XB_TMO], 1u); break; } } } } while (0)

struct XcdBarrier {
    unsigned* bar; unsigned x;
    volatile LAS unsigned* st;
};

__device__ __forceinline__ XcdBarrier xcd_barrier_post(unsigned* bar, volatile LAS unsigned* st) {
    XcdBarrier b; b.bar = bar; b.x = xb_xcc_id(); b.st = st;
    if (threadIdx.x == 0) (void)xb_add(&bar[XB_XCNT(b.x)], 1u);
    return b;
}
__device__ __forceinline__ void xcd_barrier_complete(unsigned* bar, unsigned x, unsigned& nloc, unsigned& nx) {
    const unsigned G = gridDim.x * gridDim.y * gridDim.z;
    unsigned sum, cnt, mine, sp = 0u;
    for (;;) {
        sum = 0u; cnt = 0u; mine = 0u;
#pragma unroll
        for (unsigned j = 0; j < 16; ++j) { const unsigned c = xb_ld(&bar[XB_XCNT(j)]); sum += c; cnt += (c > 0u) ? 1u : 0u; mine = (j == x) ? c : mine; }
        if (sum == G) break;
        __builtin_amdgcn_s_sleep(1);
        if ((++sp & 255u) == 0u) { if (xb_ld(&bar[XB_TMO])) break; if (sp > XB_SPIN_CAP) { atomicAdd(&bar[XB_TMO], 1u); break; } }
    }
    nloc = mine > 0u ? mine : 1u; nx = cnt > 0u ? cnt : 1u;
}

__device__ __forceinline__ void xcd_barrier(const XcdBarrier& b) {
    asm volatile("s_waitcnt vmcnt(0)" ::: "memory");
    __syncthreads();
    if (threadIdx.x == 0) {
        unsigned* bar = b.bar;
        __builtin_amdgcn_s_waitcnt(0);
        unsigned nloc = b.st[0], nx = b.st[1];
        if (nloc == 0u) { xcd_barrier_complete(bar, b.x, nloc, nx); b.st[0] = nloc; b.st[1] = nx; }
        const unsigned old = xb_add(&bar[XB_XSUB(b.x)], 1u);
        const unsigned gen = old / nloc;
        if (old + 1u == (gen + 1u) * nloc) {
            __builtin_amdgcn_fence(__ATOMIC_RELEASE, "agent");
            asm volatile("s_waitcnt vmcnt(0)" ::: "memory");
            const unsigned og = xb_add(&bar[XB_TOP], 1u);
            const unsigned tg = og / nx;
            if (og + 1u == (tg + 1u) * nx) xb_add(&bar[XB_TOPGEN], 1u);
            else XB_SPIN(xb_ld(&bar[XB_TOPGEN]) == tg, bar);
            __builtin_amdgcn_fence(__ATOMIC_ACQUIRE, "agent");
            xb_add(&bar[XB_XGEN(b.x)], 1u);
            asm volatile("s_waitcnt vmcnt(0)" ::: "memory");
        } else {
            XB_SPIN(xb_ld(&bar[XB_XGEN(b.x)]) == gen, bar);
            __builtin_amdgcn_fence(__ATOMIC_ACQUIRE, "agent");
            asm volatile("s_waitcnt vmcnt(0)" ::: "memory");
        }
    }
    __syncthreads();
}

constexpr int N_PHASES = 2 + 9 * DEPTH;
struct Args { const float* in[26]; float* out; unsigned char* ws; int ph_lo, ph_hi; };
__global__ void __launch_bounds__(NWAVES * 64, 2) hymba_fwd(Args args) {
    extern __shared__ __attribute__((aligned(16))) unsigned char lds[];
    Frame F;
    F.lds = (LAS unsigned char*)lds;
    F.MISC = (volatile LAS unsigned*)(F.lds + MISC_OFF);
    F.tid = threadIdx.x; F.lane = F.tid & 63; F.wave = __builtin_amdgcn_readfirstlane(F.tid >> 6);
    F.G = gridDim.x; { const int bx = blockIdx.x; F.vcu = (F.G % 8 == 0) ? (bx % 8) * (F.G / 8) + bx / 8 : bx; }
    F.ws = args.ws; F.out = args.out; F.ctl = (gu32*)(args.ws + WS_CTL);
    for (int u = F.tid; u < (LDS_BYTES - LDSCTL_OFF) / 4; u += NWAVES * 64) ((LAS unsigned*)(F.lds + LDSCTL_OFF))[u] = 0u;
    __syncthreads();
    const int lo = args.ph_lo, hi = args.ph_hi;
    XcdBarrier bar; bar.bar = (unsigned*)(F.ctl + CW_BAR); bar.x = 0; bar.st = nullptr;
    if (hi - lo > 1) bar = xcd_barrier_post((unsigned*)(F.ctl + CW_BAR), F.MISC + 8);
#ifndef PHMASK
#define PHMASK 0x7ff
#endif
#define PH(k) (lo <= (k) && (k) < hi)
#define PHK(k, kind) (((PHMASK >> (kind)) & 1) && lo <= (k) && (k) < hi)
#define SEAM(k) do { if (PH(k) && PH((k) + 1)) xcd_barrier(bar); } while (0)
    unsigned char* ws = args.ws;
    bf16_t* HB = (bf16_t*)(ws + WS_HB); bf16_t* QB_ = (bf16_t*)(ws + WS_Q);
    if (PHK(0, 0)) p0_prologue(F);
    SEAM(0);
    if (PHK(1, 1)) p1_htransform(F);
    SEAM(1);
    for (int l = 0; l < DEPTH; ++l) {
        const int pb = 2 + 9 * l;
        const float* mod = (const float*)(ws + WS_MOD) + (size_t)l * NB * 6144;
        if (PHK(pb + 0, 2)) {
            pg8::DenseOrder S; S.init(HB, (const bf16_t*)(ws + WS_WIN) + (size_t)l * INC * DM, MTOK, INC, DM, F.G, (int)blockIdx.x);
            pg8::EpiInProj E{QB_, WS_QSTRIDE / 2, (const float*)(ws + WS_COS), (const float*)(ws + WS_SIN), 1.0f};
            pg8::gemm_phase<pg8::EpiInProj, pg8::DenseOrder, false>(F.lds, DM, nullptr, S, E);
        }
        SEAM(pb + 0);
        if (PHK(pb + 1, 3)) {
            att::attn_phase((char*)lds, QB_, (const bf16_t*)(ws + WS_Q + WS_QSTRIDE), (const bf16_t*)(ws + WS_Q + 2 * WS_QSTRIDE), (bf16_t*)(ws + WS_O12), F.vcu, F.G);
            __syncthreads();
            p_sg(F, l);
        }
        SEAM(pb + 1);
        if (PHK(pb + 2, 4)) p_diffnorm(F, l);
        SEAM(pb + 2);
        if (PHK(pb + 3, 5)) {
            pg8::DenseOrder S; S.init(ws + WS_MIXA, (const bf16_t*)(ws + WS_WOUT) + (size_t)l * DM * DM, MTOK, DM, DM, F.G, (int)blockIdx.x);
            pg8::EpiOutProj E{l == 0 ? INP(I_X) : F.out, F.out, mod + 2048};
            pg8::gemm_phase<pg8::EpiOutProj, pg8::DenseOrder, false>(F.lds, DM, nullptr, S, E);
        }
        SEAM(pb + 3);
        if (PHK(pb + 4, 6)) p_ln1(F, l);
        SEAM(pb + 4);
        if (PHK(pb + 5, 7)) p_router(F, l);
        SEAM(pb + 5);
        if (PHK(pb + 6, 8)) {
            const int TP = expert_setup(F, l, true);
            pg8::ExpertOrder S{(const LAS int*)(F.lds + PPRE_OFF), (const LAS int*)(F.lds + PPRE_OFF) + 40, TP, F.G, (int)blockIdx.x, (const char*)HB,
                               (const char*)(ws + WS_WGU) + (size_t)l * NEXP * 1024 * DM * 2, 0, (size_t)1024 * DM * 2, (size_t)256 * DM * 2, true};
            pg8::EpiGateUp E{(bf16_t*)(ws + WS_ACT)};
            pg8::gemm_phase<pg8::EpiGateUp, pg8::ExpertOrder, true>(F.lds, DM, (const LAS unsigned*)(F.lds + IDX_OFF), S, E);
        }
        SEAM(pb + 6);
        if (PHK(pb + 7, 9)) {
            const int TP = expert_setup(F, l, false);
            pg8::ExpertOrder S{(const LAS int*)(F.lds + PPRE_OFF), (const LAS int*)(F.lds + PPRE_OFF) + 40, TP, F.G, (int)blockIdx.x, (const char*)(ws + WS_ACT),
                               (const char*)(ws + WS_WD) + (size_t)l * NEXP * DM * DEXP * 2, (size_t)256 * DEXP * 2, (size_t)DM * DEXP * 2, (size_t)256 * DEXP * 2, false};
            pg8::EpiDown E{(bf16_t*)(ws + WS_Y2), (const unsigned*)(ws + WS_LST), (const float*)(ws + WS_CW)};
            pg8::gemm_phase<pg8::EpiDown, pg8::ExpertOrder, false>(F.lds, DEXP, nullptr, S, E);
        }
        SEAM(pb + 7);
        if (PHK(pb + 8, 10)) p_ln2(F, l);
        SEAM(pb + 8);
    }
#undef PH
#undef SEAM
}

#ifndef MK_ONE_LAUNCH
#define MK_ONE_LAUNCH 0
#endif
extern "C" void kernel_launch(void* const* d_in, const int* in_sizes, int n_in, void* d_out, int out_size, void* d_ws, size_t ws_size, hipStream_t stream) {
    static int grid = 0;
    if (grid == 0) {
        if (n_in != 26 || in_sizes[0] != MTOK * DM || out_size != MTOK * DM || ws_size < WS_END) { fprintf(stderr, "kernel_launch: unexpected shapes (n_in %d, in0 %d, out %d, ws %zu); nothing launched\n", n_in, n_in > 0 ? in_sizes[0] : -1, out_size, ws_size); grid = -1; return; }
        int dev = 0, cus = 0, per_cu = 0;
        if (hipGetDevice(&dev) != hipSuccess || hipDeviceGetAttribute(&cus, hipDeviceAttributeMultiprocessorCount, dev) != hipSuccess) { grid = -1; return; }
        if (hipFuncSetAttribute((const void*)hymba_fwd, hipFuncAttributeMaxDynamicSharedMemorySize, LDS_BYTES) != hipSuccess) { fprintf(stderr, "kernel_launch: hipFuncSetAttribute failed\n"); grid = -1; return; }
        if (hipOccupancyMaxActiveBlocksPerMultiprocessor(&per_cu, (const void*)hymba_fwd, NWAVES * 64, LDS_BYTES) != hipSuccess || per_cu < 1) { fprintf(stderr, "kernel_launch: occupancy query reports %d blocks per CU\n", per_cu); }
        (void)hipGetLastError();
        grid = cus;
    }
    if (grid < 0) return;
    if (hipMemsetAsync((char*)d_ws + WS_CTL, 0, CTL_ZERO_BYTES, stream) != hipSuccess) return;
    Args a{};
    for (int i = 0; i < 26; ++i) a.in[i] = (const float*)d_in[i];
    a.out = (float*)d_out; a.ws = (unsigned char*)d_ws;
#if MK_ONE_LAUNCH
    a.ph_lo = 0; a.ph_hi = N_PHASES;
    hipLaunchKernelGGL(hymba_fwd, dim3(grid), dim3(NWAVES * 64), LDS_BYTES, stream, a);
#else
    for (int p = 0; p < N_PHASES; ++p) { a.ph_lo = p; a.ph_hi = p + 1;
        hipLaunchKernelGGL(hymba_fwd, dim3(grid), dim3(NWAVES * 64), LDS_BYTES, stream, a); }
#endif
}
```

```cpp
#include <hip/hip_runtime.h>
#include <hip/hip_bf16.h>
#include <cstdio>
#include <cstdint>
#include <cmath>

#define LAS __attribute__((address_space(3)))
#define GAS __attribute__((address_space(1)))
typedef unsigned short bf16_t;
typedef short bf16x8 __attribute__((ext_vector_type(8)));
typedef short s16x4 __attribute__((ext_vector_type(4)));
typedef float f32x2 __attribute__((ext_vector_type(2)));
typedef float f32x4 __attribute__((ext_vector_type(4)));
typedef float f32x16 __attribute__((ext_vector_type(16)));
typedef unsigned u32x2 __attribute__((ext_vector_type(2)));
typedef unsigned u32x4 __attribute__((ext_vector_type(4)));
typedef GAS unsigned gu32;
#define RLX_AGENT __ATOMIC_RELAXED, __HIP_MEMORY_SCOPE_AGENT
#define LDS_WAIT() asm volatile("s_waitcnt lgkmcnt(0)" ::: "memory")
#define VM_WAIT() asm volatile("s_waitcnt vmcnt(0)" ::: "memory")

constexpr int NB = 8, SEQ = 8192, DM = 1024, MTOK = NB * SEQ, DEPTH = 2;
constexpr int INC = 2560;
constexpr int NEXP = 32, DEXP = 512, LCAP = 65536;
constexpr int MAXPAN = 512 + NEXP;
constexpr float LN_EPS = 1e-5f;
constexpr float ALPHA = 1.41421356237309515f;
constexpr int NWAVES = 8;

constexpr size_t MiB = 1u << 20;
constexpr size_t WS_CTL = 0, CTL_ZERO_BYTES = 1 * MiB;
constexpr size_t WS_MOD = 1 * MiB;
constexpr size_t WS_SCAL = 1 * MiB + 512 * 1024;
constexpr size_t WS_COS = 2 * MiB, WS_SIN = 3 * MiB;
constexpr size_t WS_RIMG = 4 * MiB;
constexpr size_t WS_WSP = 4 * MiB + 512 * 1024;
constexpr size_t WS_WIN = 6 * MiB;
constexpr size_t WS_WOUT = 16 * MiB;
constexpr size_t WS_WGU = 20 * MiB;
constexpr size_t WS_WD = 148 * MiB;
constexpr size_t WS_LST = 212 * MiB;
constexpr size_t WS_CW = 220 * MiB;
constexpr size_t WS_HB = 228 * MiB;
constexpr size_t WS_Q = 356 * MiB;
constexpr size_t WS_QSTRIDE = 64 * MiB;
constexpr size_t WS_O12 = 676 * MiB;
constexpr size_t WS_MIXA = 804 * MiB;
constexpr size_t WS_ACT = 356 * MiB;
constexpr size_t WS_Y2 = 492 * MiB;
constexpr size_t WS_END = 932 * MiB;
static_assert(WS_ACT + (size_t)MAXPAN * 256 * 512 * 2 <= WS_Y2 && WS_Y2 + (size_t)MTOK * 2 * 1024 * 2 <= WS_MIXA, "overlay map");
constexpr int CW_TMO = 0;
constexpr int CW_CNT = 1024;
constexpr int CW_BAR = 4096;

constexpr int RING_BYTES = 131072;
constexpr int IDX_OFF = RING_BYTES, IDX_SLOTS = 10, IDX_BYTES = IDX_SLOTS * 1024;
constexpr int PPRE_OFF = IDX_OFF + IDX_BYTES;
constexpr int LDSCTL_OFF = PPRE_OFF + 512, MISC_OFF = LDSCTL_OFF + 64;
constexpr int LDS_BYTES = 147456;
static_assert(MISC_OFF + 128 <= LDS_BYTES, "LDS map");

__device__ __forceinline__ unsigned cvtpk(float lo, float hi) { f32x2 v = {lo, hi}; typedef __bf16 bf2 __attribute__((ext_vector_type(2))); bf2 b = __builtin_convertvector(v, bf2); return __builtin_bit_cast(unsigned, b); }
__device__ __forceinline__ float bf2f(unsigned short b) { return __uint_as_float((unsigned)b << 16); }
__device__ __forceinline__ float bflo(unsigned w) { return __uint_as_float(w << 16); }
__device__ __forceinline__ float bfhi(unsigned w) { return __uint_as_float(w & 0xffff0000u); }
__device__ __forceinline__ float wave_sum(float v) {
#pragma unroll
    for (int o = 1; o < 64; o <<= 1) v += __shfl_xor(v, o);
    return v;
}
__device__ __forceinline__ f32x2 gelu_pk(f32x2 v) {
    const f32x2 av = __builtin_elementwise_abs(v), d = av * 0.2316418882f + 1.0f;
    f32x2 t; t.x = __builtin_amdgcn_rcpf(d.x); t.y = __builtin_amdgcn_rcpf(d.y);
    f32x2 q = t * 0.5307027145f + (-0.7265760135f); q = q * t + 0.7107068705f; q = q * t + (-0.142248368f); q = q * t + 0.127414796f; q = q * t;
    const f32x2 s = (v * v) * (-0.72134752044f);
    f32x2 e; e.x = __builtin_amdgcn_exp2f(s.x); e.y = __builtin_amdgcn_exp2f(s.y);
    const f32x2 m = v * (q * e), r = v - m;
    f32x2 o; o.x = v.x < 0.f ? m.x : r.x; o.y = v.y < 0.f ? m.y : r.y; return o;
}
__device__ __forceinline__ f32x4 gelu4(f32x4 v) { const f32x2 a = gelu_pk((f32x2){v[0], v[1]}), b = gelu_pk((f32x2){v[2], v[3]}); return (f32x4){a.x, a.y, b.x, b.y}; }
__device__ __forceinline__ float silu1(float x) { return x * __builtin_amdgcn_rcpf(1.0f + __builtin_amdgcn_exp2f(-1.4426950408889634f * x)); }
namespace pg8 {
constexpr int BM = 256, BK = 64, HALF = 128, HTB = HALF * BK * 2, STAGE_BYTES = 8 * HTB, NXCD = 8, WGM = 8;
__device__ __forceinline__ int lds_byte(int r, int c) { const int st = (r >> 4) * 2 + (c >> 5), rr = r & 15, cc = c & 31, ob = rr * 64 + cc * 2; return st * 1024 + (ob ^ (((ob >> 9) & 1) << 5)); }
__device__ __forceinline__ void stage_rc(int b, int& R, int& C) { const int st = b / 1024, sb = b % 1024, swz = sb ^ (((sb >> 9) & 1) << 5); R = (st >> 1) * 16 + swz / 64; C = (st & 1) * 32 + (swz % 64) / 2; }

struct Unit { const char* A; const char* B; int pm, pn, e, nrows, row0, slot; };

struct DenseOrder {
    int nM, nN, nwg, G, c; const char* A; const char* B; size_t tstep;
    __device__ void init(const void* A_, const void* B_, int Mrows, int N, int K, int G_, int c_) { nM = Mrows / BM; nN = N / BM; nwg = nM * nN; G = G_; c = c_; A = (const char*)A_; B = (const char*)B_; tstep = (size_t)BM * K * 2; }
    __device__ bool next(int i, Unit& u) const {
        const long L = (long)i * G + c; if (L >= nwg) return false;
        int wgid = (int)L; { const int q = nwg / NXCD, r = nwg % NXCD, xcd = wgid % NXCD, off = wgid / NXCD; wgid = (xcd < r ? xcd * (q + 1) : r * (q + 1) + (xcd - r) * q) + off; }
        const int nig = WGM * nN, gid = wgid / nig, fm = gid * WGM, gsz = (nM - fm) < WGM ? (nM - fm) : WGM;
        u.pm = fm + ((wgid % nig) % gsz); u.pn = (wgid % nig) / gsz; u.e = 0; u.nrows = 256; u.row0 = 0; u.slot = 0;
        u.A = A + (size_t)u.pm * tstep; u.B = B + (size_t)u.pn * tstep; return true;
    }
};
struct ExpertOrder {
    const LAS int* ppre; const LAS int* cnt; int TP, G, c; const char* A; const char* B; size_t a_tstep, b_estride, b_tstep; bool gather;
    __device__ bool next(int i, Unit& u) const {
        const int L = i * G + c; if (L >= 4 * TP) return false;
        const int p = L >> 2; int e = 0;
        while (e < NEXP - 1 && ppre[e + 1] <= p) ++e;
        u.pm = p; u.pn = L & 3; u.e = e; u.row0 = (p - ppre[e]) * 256; { const int rem = cnt[e] - u.row0; u.nrows = rem < 256 ? rem : 256; } u.slot = i;
        u.A = gather ? A : A + (size_t)p * a_tstep; u.B = B + (size_t)e * b_estride + (size_t)u.pn * b_tstep; return true;
    }
};

template <class Epi, class Sched, bool GATHER>
__device__ __forceinline__ void gemm_phase(LAS unsigned char* lds, const int K, const LAS unsigned* gidx, const Sched& S, const Epi& E) {
    int tid_ = threadIdx.x; asm volatile("" : "+v"(tid_));
    const int tid = tid_, wid = __builtin_amdgcn_readfirstlane(tid >> 6), lane = tid & 63, wr = wid >> 2, wc = wid & 3, fr = lane & 15, fq = lane >> 4;
    const int nt = K / BK;
    unsigned voff[2]; int rA[2]; unsigned cA2[2];
#pragma unroll
    for (int i = 0; i < 2; ++i) { int R, C; stage_rc(tid * 16 + i * 8192, R, C); voff[i] = (unsigned)(R * K + C) * 2u; rA[i] = R; cA2[i] = (unsigned)C * 2u; }
    const size_t kstep = (size_t)(BK * 2);
    const size_t hstep = (size_t)HALF * K * 2;
    const unsigned ldsw = (unsigned)wid * 1024u;
    const int aoff = lds_byte(wr * 64 + fr, fq * 8), boff = lds_byte(wc * 32 + fr, fq * 8);
#define PG8_SA(b, h) (((b) * 2 + (h)) * HTB)
#define PG8_SB(b, h) ((4 + (b) * 2 + (h)) * HTB)
#define PG8_STAGE_B(bufoff, gbase) do { _Pragma("unroll") for (int _i = 0; _i < 2; ++_i) \
        __builtin_amdgcn_global_load_lds((const unsigned*)((const char*)(gbase) + voff[_i]), (LAS unsigned*)(lds + (bufoff) + ldsw + _i * 8192), 16, 0, 0); } while (0)
#define PG8_STAGE_A(bufoff, h, uptr, NEXT) do { _Pragma("unroll") for (int _i = 0; _i < 2; ++_i) { \
        const unsigned _vo = GATHER ? ((NEXT) ? ngo[h][_i] : cgo[h][_i]) : voff[_i]; \
        __builtin_amdgcn_global_load_lds((const unsigned*)((const char*)(uptr) + (GATHER ? (size_t)0 : (size_t)(h) * hstep) + _vo), (LAS unsigned*)(lds + (bufoff) + ldsw + _i * 8192), 16, 0, 0); } } while (0)
#define PG8_LDA(dst, b, h) do { _Pragma("unroll") for (int m = 0; m < 4; ++m) _Pragma("unroll") for (int k = 0; k < 2; ++k) dst[m][k] = *(const LAS bf16x8*)(lds + PG8_SA(b, h) + aoff + m * 2048 + k * 1024); } while (0)
#define PG8_LDB(dst, b, h) do { _Pragma("unroll") for (int n = 0; n < 2; ++n) _Pragma("unroll") for (int k = 0; k < 2; ++k) dst[n][k] = *(const LAS bf16x8*)(lds + PG8_SB(b, h) + boff + n * 2048 + k * 1024); } while (0)
#define PG8_MMA(ai, bj, At, Bt) do { __builtin_amdgcn_s_setprio(1); _Pragma("unroll") for (int m = 0; m < 4; ++m) _Pragma("unroll") for (int n = 0; n < 2; ++n) _Pragma("unroll") for (int k = 0; k < 2; ++k) \
        acc[ai][bj][m][n] = __builtin_amdgcn_mfma_f32_16x16x32_bf16(Bt[n][k], At[m][k], acc[ai][bj][m][n], 0, 0, 0); __builtin_amdgcn_s_setprio(0); } while (0)
#define PG8_WAIT_V(n) asm volatile("s_waitcnt vmcnt(" #n ")" ::: "memory")
#define PG8_WAIT_L(n) asm volatile("s_waitcnt lgkmcnt(" #n ")" ::: "memory")
#define PG8_BAR __builtin_amdgcn_s_barrier()
#define PG8_SCHED __builtin_amdgcn_sched_barrier(0)
#define PG8_GO(dst, slot) do { if constexpr (GATHER) { _Pragma("unroll") for (int _h = 0; _h < 2; ++_h) _Pragma("unroll") for (int _i = 0; _i < 2; ++_i) \
        dst[_h][_i] = gidx[(slot) * 256 + _h * 128 + rA[_i]] * (unsigned)(K * 2) + cA2[_i]; } } while (0)
    Unit cur, nxt; int ui = 0;
    if (!S.next(0, cur)) return;
    unsigned cgo[2][2] = {{0u, 0u}, {0u, 0u}}, ngo[2][2] = {{0u, 0u}, {0u, 0u}};
    PG8_GO(cgo, cur.slot);
    f32x4 acc[2][2][4][2];
#pragma unroll
    for (int a = 0; a < 2; ++a)
#pragma unroll
        for (int b = 0; b < 2; ++b)
#pragma unroll
            for (int m = 0; m < 4; ++m)
#pragma unroll
                for (int n = 0; n < 2; ++n) acc[a][b][m][n] = (f32x4){0.f, 0.f, 0.f, 0.f};
    bf16x8 At[4][2], B0[2][2], B1[2][2];
    const char* cA = cur.A; const char* cB = cur.B;
    PG8_STAGE_B(PG8_SB(0, 0), cB); PG8_STAGE_B(PG8_SB(0, 1), cB + hstep); PG8_STAGE_A(PG8_SA(0, 0), 0, cA, false); PG8_STAGE_A(PG8_SA(0, 1), 1, cA, false);
    if (wr == 1) PG8_BAR;
    PG8_WAIT_V(2); PG8_BAR;
    PG8_STAGE_B(PG8_SB(1, 0), cB + kstep); PG8_STAGE_A(PG8_SA(1, 0), 0, cA + kstep, false); PG8_STAGE_B(PG8_SB(1, 1), cB + hstep + kstep);
    PG8_WAIT_V(6); PG8_BAR;
    for (;;) {
        const bool has_next = S.next(ui + 1, nxt);
        const char* nA = has_next ? nxt.A : cA; const char* nB = has_next ? nxt.B : cB;
        if constexpr (GATHER) { if (has_next) { PG8_GO(ngo, nxt.slot); } else {
#pragma unroll
            for (int h = 0; h < 2; ++h)
#pragma unroll
                for (int i = 0; i < 2; ++i) ngo[h][i] = cgo[h][i]; } }
        for (int t = 0; t < nt; t += 2) {
            const bool last = (t == nt - 2);
            const char* a1 = cA + (size_t)(t + 1) * kstep;
            const char* a2 = last ? nA : cA + (size_t)(t + 2) * kstep; const char* b2 = last ? nB : cB + (size_t)(t + 2) * kstep;
            const char* a3 = a2 + kstep; const char* b3 = b2 + kstep;
            PG8_LDB(B0, 0, 0); PG8_LDB(B1, 0, 1); PG8_SCHED; PG8_LDA(At, 0, 0); PG8_STAGE_A(PG8_SA(1, 1), 1, a1, false);
            PG8_WAIT_V(8); PG8_WAIT_L(0); PG8_BAR; PG8_MMA(0, 0, At, B0); PG8_MMA(0, 1, At, B1); PG8_BAR; PG8_SCHED;
            PG8_LDA(At, 0, 1); PG8_STAGE_B(PG8_SB(0, 0), b2); PG8_STAGE_B(PG8_SB(0, 1), b2 + hstep); PG8_STAGE_A(PG8_SA(0, 0), 0, a2, last);
            PG8_WAIT_V(8); PG8_WAIT_L(0); PG8_BAR; PG8_MMA(1, 0, At, B0); PG8_MMA(1, 1, At, B1); PG8_BAR; PG8_SCHED;
            PG8_LDB(B0, 1, 0); PG8_LDB(B1, 1, 1); PG8_SCHED; PG8_LDA(At, 1, 0); PG8_STAGE_A(PG8_SA(0, 1), 1, a2, last);
            PG8_WAIT_V(8); PG8_WAIT_L(0); PG8_BAR; PG8_MMA(0, 0, At, B0); PG8_MMA(0, 1, At, B1); PG8_BAR; PG8_SCHED;
            PG8_LDA(At, 1, 1); PG8_STAGE_B(PG8_SB(1, 0), b3); PG8_STAGE_B(PG8_SB(1, 1), b3 + hstep); PG8_STAGE_A(PG8_SA(1, 0), 0, a3, last);
            PG8_WAIT_V(8); PG8_WAIT_L(0); PG8_BAR; PG8_MMA(1, 0, At, B0); PG8_MMA(1, 1, At, B1); PG8_BAR; PG8_SCHED;
        }
        if (wr == 0) PG8_BAR;
        E(acc, cur, wr, wc, fr, fq);
        if (!has_next) break;
#pragma unroll
        for (int a = 0; a < 2; ++a)
#pragma unroll
            for (int b = 0; b < 2; ++b)
#pragma unroll
                for (int m = 0; m < 4; ++m)
#pragma unroll
                    for (int n = 0; n < 2; ++n) acc[a][b][m][n] = (f32x4){0.f, 0.f, 0.f, 0.f};
        cur = nxt; cA = nA; cB = nB; ++ui;
        if constexpr (GATHER) {
#pragma unroll
            for (int h = 0; h < 2; ++h)
#pragma unroll
                for (int i = 0; i < 2; ++i) cgo[h][i] = ngo[h][i]; }
        if (wr == 1) PG8_BAR;
    }
    PG8_WAIT_V(0);
    PG8_BAR;
#undef PG8_SA
#undef PG8_SB
#undef PG8_STAGE_A
#undef PG8_STAGE_B
#undef PG8_LDA
#undef PG8_LDB
#undef PG8_MMA
#undef PG8_WAIT_V
#undef PG8_WAIT_L
#undef PG8_BAR
#undef PG8_SCHED
#undef PG8_GO
}

__device__ __forceinline__ u32x4 pack8(f32x4 a, f32x4 b) { u32x4 w; w.x = cvtpk(a[0], a[1]); w.y = cvtpk(a[2], a[3]); w.z = cvtpk(b[0], b[1]); w.w = cvtpk(b[2], b[3]); return w; }

struct EpiInProj {
    bf16_t* out0; size_t type_stride; const float* cosT; const float* sinT; float qscale;
    __device__ __forceinline__ void operator()(const f32x4 (&acc)[2][2][4][2], const Unit& u, int wr, int wc, int fr, int fq) const {
        const int type = u.pn >> 1;
        bf16_t* base = out0 + (size_t)type * type_stride + (u.pn & 1) * 256 + wc * 32 + fq * 8;
        const int row0 = u.pm * BM + wr * 64 + fr;
        if (type <= 1) {
            const float sc = (type == 0) ? qscale : 1.0f;
            const int ci = 16 * (wc & 1) + 4 * fq;
#pragma unroll
            for (int ai = 0; ai < 2; ++ai)
#pragma unroll
                for (int m = 0; m < 4; ++m) { const int row = row0 + ai * HALF + m * 16; const int pos = row & (SEQ - 1);
                    const f32x4 cs = *(const f32x4*)(cosT + pos * 32 + ci) * sc, sn = *(const f32x4*)(sinT + pos * 32 + ci) * sc;
                    bf16_t* rowp = base + (size_t)row * 512;
#pragma unroll
                    for (int bj = 0; bj < 2; ++bj) { const f32x4 x1 = acc[ai][bj][m][0], x2 = acc[ai][bj][m][1];
                        *(u32x4*)(rowp + bj * HALF) = pack8(x1 * cs - x2 * sn, x2 * cs + x1 * sn); } }
        } else if (type == 2) {
#pragma unroll
            for (int ai = 0; ai < 2; ++ai)
#pragma unroll
                for (int m = 0; m < 4; ++m) { bf16_t* rowp = base + (size_t)(row0 + ai * HALF + m * 16) * 512;
#pragma unroll
                    for (int bj = 0; bj < 2; ++bj) *(u32x4*)(rowp + bj * HALF) = pack8(acc[ai][bj][m][0], acc[ai][bj][m][1]); }
        } else {
#pragma unroll
            for (int ai = 0; ai < 2; ++ai)
#pragma unroll
                for (int m = 0; m < 4; ++m) { bf16_t* rowp = base + (size_t)(row0 + ai * HALF + m * 16) * 512;
#pragma unroll
                    for (int bj = 0; bj < 2; ++bj) *(u32x4*)(rowp + bj * HALF) = pack8(gelu4(acc[ai][bj][m][0]), gelu4(acc[ai][bj][m][1])); }
        }
    }
};
struct EpiOutProj {
    const float* xin; float* out; const float* gate;
    __device__ __forceinline__ void operator()(const f32x4 (&acc)[2][2][4][2], const Unit& u, int wr, int wc, int fr, int fq) const {
        const int b = u.pm >> 5;
        const int col0 = u.pn * BM + wc * 32 + 4 * fq; const float* gp = gate + b * 6144 + col0;
        f32x4 g[2][2];
#pragma unroll
        for (int bj = 0; bj < 2; ++bj)
#pragma unroll
            for (int n = 0; n < 2; ++n) g[bj][n] = *(const f32x4*)(gp + bj * HALF + n * 16) + 1.0f;
#pragma unroll
        for (int ai = 0; ai < 2; ++ai)
#pragma unroll
            for (int m = 0; m < 4; ++m) { const size_t off = (size_t)(u.pm * BM + ai * HALF + wr * 64 + m * 16 + fr) * DM + col0;
#pragma unroll
                for (int bj = 0; bj < 2; ++bj)
#pragma unroll
                    for (int n = 0; n < 2; ++n) { const f32x4 xi = *(const f32x4*)(xin + off + bj * HALF + n * 16);
                        *(f32x4*)(out + off + bj * HALF + n * 16) = xi * ALPHA + g[bj][n] * acc[ai][bj][m][n]; } }
    }
};
struct EpiGateUp {
    bf16_t* act;
    __device__ __forceinline__ void operator()(const f32x4 (&acc)[2][2][4][2], const Unit& u, int wr, int wc, int fr, int fq) const {
        bf16_t* base = act + (size_t)(u.pm * BM + wr * 64 + fr) * DEXP + u.pn * 128 + wc * 32 + fq * 8;
#pragma unroll
        for (int ai = 0; ai < 2; ++ai)
#pragma unroll
            for (int m = 0; m < 4; ++m) { f32x4 a[2];
#pragma unroll
                for (int bj = 0; bj < 2; ++bj) { const f32x4 g = acc[ai][bj][m][0], up = acc[ai][bj][m][1];
                    a[bj] = (f32x4){silu1(g[0]) * up[0], silu1(g[1]) * up[1], silu1(g[2]) * up[2], silu1(g[3]) * up[3]}; }
                *(u32x4*)(base + (size_t)(ai * HALF + m * 16) * DEXP) = pack8(a[0], a[1]); }
    }
};
struct EpiDown {
    bf16_t* y2; const unsigned* lst; const float* cw;
    __device__ __forceinline__ void operator()(const f32x4 (&acc)[2][2][4][2], const Unit& u, int wr, int wc, int fr, int fq) const {
        const int colb = u.pn * BM + wc * 32 + fq * 8; const size_t lb = (size_t)u.e * LCAP + u.row0;
        unsigned ent[2][4]; float w[2][4];
#pragma unroll
        for (int ai = 0; ai < 2; ++ai)
#pragma unroll
            for (int m = 0; m < 4; ++m) { const int r = ai * HALF + wr * 64 + m * 16 + fr; const bool ok = r < u.nrows;
                ent[ai][m] = ok ? lst[lb + r] : 0xffffffffu; w[ai][m] = ok ? cw[lb + r] : 0.f; }
#pragma unroll
        for (int ai = 0; ai < 2; ++ai)
#pragma unroll
            for (int m = 0; m < 4; ++m) { if (ent[ai][m] != 0xffffffffu) { bf16_t* rowp = y2 + (size_t)ent[ai][m] * DM + colb; const float ww = w[ai][m];
#pragma unroll
                for (int bj = 0; bj < 2; ++bj) *(u32x4*)(rowp + bj * HALF) = pack8(acc[ai][bj][m][0] * ww, acc[ai][bj][m][1] * ww); } }
    }
};
}
namespace att {
constexpr int NW = 8, QBLK = 32, KVBLK = 64, QB = NW * QBLK, DK = 64, DV = 128, PQ = 512, PO = 1024, NQB = SEQ / QB;
constexpr int SHM_V = KVBLK * DV * 2, SHM_K = KVBLK * DK * 2;
constexpr int LDS_BYTES = 2 * SHM_V + 2 * SHM_K + NW * 64 * 4;
constexpr float SCALE = 0.125f, THR = 8.f;
#define KSWZ(row, colB) ((row) * 128 + ((colB) ^ ((((row) >> 1) & 7) << 4)))
#define SBAR() __builtin_amdgcn_sched_barrier(0)
__device__ __forceinline__ int v_st(int k, int c) { const int kk = (k & ~0xC) | ((k & 4) << 1) | ((k & 8) >> 1); return ((kk >> 3) * 4 + (c >> 5)) * 512 + ((kk & 7) * 32 + (c & 31)) * 2; }
__device__ __forceinline__ int v_rd_base(int lane) { return ((lane & 3) << 3) | (((lane >> 2) & 3) << 6) | (((lane >> 4) & 1) << 5) | (((lane >> 5) & 1) << 8); }
constexpr int v_rd_off(int d0, int ks, int half) { return d0 * 512 + ks * 4096 + half * 2048; }
__device__ __forceinline__ int crow(int r, int hi) { return (r & 3) + 8 * (r >> 2) + 4 * hi; }
__device__ __forceinline__ bf16x8 load8(const bf16_t* p) { return *reinterpret_cast<const bf16x8*>(p); }
__device__ __forceinline__ void mask_tile(f32x16& p0, f32x16& p1, int dq) {
    const float NEG = -__builtin_inff();
#pragma unroll
    for (int r = 0; r < 16; ++r) {
        const int c = (r & 3) + 8 * (r >> 2);
        if (dq - c < 0) p0[r] = NEG;
        if (dq - c - 32 < 0) p1[r] = NEG;
    }
}
__device__ __forceinline__ void partialSM(f32x16& p0, f32x16& p1, float& m_reg, float& mn, float& alpha) {
    float pmax = p0[0];
#pragma unroll
    for (int r = 1; r < 16; ++r) pmax = fmaxf(pmax, p0[r]);
#pragma unroll
    for (int r = 0; r < 16; ++r) pmax = fmaxf(pmax, p1[r]);
    { auto rr = __builtin_amdgcn_permlane32_swap(__float_as_uint(pmax), __float_as_uint(pmax), false, false);
      pmax = fmaxf(__uint_as_float(rr[0]), __uint_as_float(rr[1])); }
    constexpr float C2 = 1.4426950408889634f * SCALE;
    if (__builtin_expect(__all((pmax - m_reg) * SCALE <= THR), 1)) { mn = m_reg; alpha = 1.f; }
    else { mn = fmaxf(m_reg, pmax); alpha = __builtin_amdgcn_exp2f((m_reg - mn) * C2); m_reg = mn; }
    const float mnL = -mn * C2;
#pragma unroll
    for (int r = 0; r < 16; ++r) p0[r] = fmaf(p0[r], C2, mnL);
#pragma unroll
    for (int r = 0; r < 16; ++r) p1[r] = fmaf(p1[r], C2, mnL);
#pragma unroll
    for (int r = 0; r < 16; ++r) p0[r] = __builtin_amdgcn_exp2f(p0[r]);
}
__device__ __forceinline__ void finishSM(f32x16& p0, f32x16& p1, float alpha, float& l_reg, bf16x8& pa0, bf16x8& pa1, bf16x8& pa2, bf16x8& pa3) {
#pragma unroll
    for (int r = 0; r < 16; ++r) p1[r] = __builtin_amdgcn_exp2f(p1[r]);
    float ps = 0;
#pragma unroll
    for (int r = 0; r < 16; ++r) ps += p0[r];
#pragma unroll
    for (int r = 0; r < 16; ++r) ps += p1[r];
    { auto rr = __builtin_amdgcn_permlane32_swap(__float_as_uint(ps), __float_as_uint(ps), false, false);
      ps = __uint_as_float(rr[0]) + __uint_as_float(rr[1]); }
    l_reg = l_reg * alpha + ps;
#define PK4(P, B_, OUT) do { unsigned a0 = cvtpk(P[B_+0], P[B_+1]), a1 = cvtpk(P[B_+2], P[B_+3]);                          \
        unsigned b0 = cvtpk(P[B_+4], P[B_+5]), b1 = cvtpk(P[B_+6], P[B_+7]);                                             \
        auto r0 = __builtin_amdgcn_permlane32_swap(a0, b0, false, false); auto r1 = __builtin_amdgcn_permlane32_swap(a1, b1, false, false); \
        u32x4 w = {r0[0], r1[0], r0[1], r1[1]}; OUT = *reinterpret_cast<bf16x8*>(&w); } while (0)
    PK4(p0, 0, pa0); PK4(p0, 8, pa1); PK4(p1, 0, pa2); PK4(p1, 8, pa3);
#undef PK4
}
template <int KB>
__device__ __forceinline__ void qkt(f32x16& p0, f32x16& p1, const char* K_lds, int r32, int hi, const bf16x8* qr) {
    p0 = f32x16{}; p1 = f32x16{};
#pragma unroll
    for (int d0 = 0; d0 < 4; ++d0) { const char* a = K_lds + KB * SHM_K + KSWZ(r32, (d0 * 16 + hi * 8) * 2);
        bf16x8 b0 = *reinterpret_cast<const bf16x8*>(a);
        bf16x8 b1 = *reinterpret_cast<const bf16x8*>(a + 32 * 128);
        p0 = __builtin_amdgcn_mfma_f32_32x32x16_bf16(b0, qr[d0], p0, 0, 0, 0);
        p1 = __builtin_amdgcn_mfma_f32_32x32x16_bf16(b1, qr[d0], p1, 0, 0, 0); }
}
template <int VB>
__device__ __forceinline__ void pv_tile(f32x16* o, int vb0, bf16x8 pa0, bf16x8 pa1, bf16x8 pa2, bf16x8 pa3) {
#define TRRD(dst, off) asm volatile("ds_read_b64_tr_b16 %0, %1 offset:%2" : "=&v"(dst) : "v"(vb0), "i"(off) : "memory")
#define PV_D0(d0) do { s16x4 l0, l1, l2, l3, h0, h1, h2, h3; constexpr int b_ = VB * SHM_V + v_rd_off(d0, 0, 0); \
        TRRD(l0, b_); TRRD(h0, b_ + 2048); TRRD(l1, b_ + 4096); TRRD(h1, b_ + 6144); TRRD(l2, b_ + 8192); TRRD(h2, b_ + 10240); TRRD(l3, b_ + 12288); TRRD(h3, b_ + 14336); \
        asm volatile("s_waitcnt lgkmcnt(0)" ::: "memory"); SBAR();   \
        o[d0] = __builtin_amdgcn_mfma_f32_32x32x16_bf16(pa0, (bf16x8){l0[0], l0[1], l0[2], l0[3], h0[0], h0[1], h0[2], h0[3]}, o[d0], 0, 0, 0);   \
        o[d0] = __builtin_amdgcn_mfma_f32_32x32x16_bf16(pa1, (bf16x8){l1[0], l1[1], l1[2], l1[3], h1[0], h1[1], h1[2], h1[3]}, o[d0], 0, 0, 0);   \
        o[d0] = __builtin_amdgcn_mfma_f32_32x32x16_bf16(pa2, (bf16x8){l2[0], l2[1], l2[2], l2[3], h2[0], h2[1], h2[2], h2[3]}, o[d0], 0, 0, 0);   \
        o[d0] = __builtin_amdgcn_mfma_f32_32x32x16_bf16(pa3, (bf16x8){l3[0], l3[1], l3[2], l3[3], h3[0], h3[1], h3[2], h3[3]}, o[d0], 0, 0, 0); } while (0)
    PV_D0(0); PV_D0(1); PV_D0(2); PV_D0(3);
#undef PV_D0
#undef TRRD
}
struct BlockRef { const bf16_t* Q; const bf16_t* K; const bf16_t* V; bf16_t* O; int P0; };
struct Seam { bf16x8 qr[4]; bf16x8 st_v0, st_v1, st_k0; };
#define VMW() asm volatile("s_waitcnt vmcnt(0)" ::: "memory")
#define VMWN(n) asm volatile("s_waitcnt vmcnt(%0)" :: "i"(n) : "memory")
#define SLOAD_H(Kp, Vp, k0) do { S.st_v0 = load8((Vp) + (size_t)((k0) + sr) * PQ + sc); S.st_v1 = load8((Vp) + (size_t)((k0) + 32 + sr) * PQ + sc); \
                                 S.st_k0 = load8((Kp) + (size_t)((k0) + krow) * PQ + kcol); } while (0)
#define SWRITE_HK(bf) do { *(bf16x8*)(K_lds + (bf) * SHM_K + kws) = S.st_k0; } while (0)
#define SWRITE_HV(bf) do { *(bf16x8*)(V_lds + (bf) * SHM_V + vst0) = S.st_v0; *(bf16x8*)(V_lds + (bf) * SHM_V + vst1) = S.st_v1; } while (0)
#define SWRITE_H(bf) do { SWRITE_HV(bf); SWRITE_HK(bf); } while (0)
__device__ __forceinline__ void prime(const BlockRef& cur, char* lds, Seam& S) {
    int tid_ = threadIdx.x; asm volatile("" : "+v"(tid_));
    const int tid = tid_, wid = __builtin_amdgcn_readfirstlane(tid >> 6), lane = tid & 63, r32 = lane & 31, hi = lane >> 5;
    const int sr = tid >> 4, sc = (tid & 15) * 8, krow = tid >> 3, kcol = (tid & 7) * 8, kws = KSWZ(krow, kcol * 2); char* K_lds = lds + 2 * SHM_V;
#pragma unroll
    for (int d0 = 0; d0 < 4; ++d0) S.qr[d0] = load8(cur.Q + (size_t)(wid * QBLK + r32) * PQ + d0 * 16 + hi * 8);
    SLOAD_H(cur.K, cur.V, 0); VMW(); SWRITE_HK(0);
    __syncthreads();
}
__device__ __forceinline__ void block(const BlockRef& cur, const BlockRef& nxt, char* lds, Seam& S) {
    int tid_ = threadIdx.x; asm volatile("" : "+v"(tid_));
    const int tid = tid_, wid = __builtin_amdgcn_readfirstlane(tid >> 6), lane = tid & 63, r32 = lane & 31, hi = lane >> 5;
    const int NT = (cur.P0 + QB) / KVBLK;
    const int qlo = cur.P0 + wid * QBLK, qm = qlo + r32 - 4 * hi;
    char* V_lds = lds; char* K_lds = lds + 2 * SHM_V;
    float* ws = (float*)(lds + 2 * SHM_V + 2 * SHM_K) + wid * 64; float* li_l = ws, * al_l = ws + 32;
    float m_reg = -1e30f, l_reg = 0; f32x16 o[4] = {};
    const int sr = tid >> 4, sc = (tid & 15) * 8, vst0 = v_st(sr, sc), vst1 = v_st(32 + sr, sc);
    const int krow = tid >> 3, kcol = (tid & 7) * 8, kws = KSWZ(krow, kcol * 2);
    const int vb0 = (int)(uintptr_t)V_lds + v_rd_base(lane);
    const bf16_t* Kh = cur.K; const bf16_t* Vh = cur.V;
#define RESC(a) do { if (__any((a) < 1.f)) { if (hi == 0) al_l[r32] = (a); asm volatile("s_waitcnt lgkmcnt(0)" ::: "memory");              \
                     _Pragma("unroll") for (int d_ = 0; d_ < 4; ++d_) _Pragma("unroll") for (int r = 0; r < 16; ++r) o[d_][r] *= al_l[crow(r, hi)]; } } while (0)
#define KBASE(t) ((t) * KVBLK)
#define MASKT(P0_, P1_, t) do { const int kb_ = KBASE(t); if (kb_ + KVBLK - 1 > qlo) mask_tile(P0_, P1_, qm - kb_); } while (0)
#define SEAM_K0() do { VMWN(4); SWRITE_HK(0); SBAR(); } while (0)
    f32x16 pA0, pA1, pB0, pB1; float mnA, mnB, alA, alB; bf16x8 pa0, pa1, pa2, pa3;
    SWRITE_HV(0); SBAR();
    if (NT > 1) SLOAD_H(Kh, Vh, KBASE(1));
    SBAR(); qkt<0>(pA0, pA1, K_lds, r32, hi, S.qr);
    MASKT(pA0, pA1, 0); partialSM(pA0, pA1, m_reg, mnA, alA);
    if (NT > 1) { VMW(); SWRITE_H(1); }
    __syncthreads();
#define HALF_STEP(PX0, PX1, mnX, alX, PY0, PY1, alY, t, KB, VB, SB) do {                                                      \
        SBAR(); qkt<KB>(PX0, PX1, K_lds, r32, hi, S.qr);                                                                      \
        finishSM(PY0, PY1, alY, l_reg, pa0, pa1, pa2, pa3); SBAR();                                                           \
        if ((t) + 1 < NT) { SLOAD_H(Kh, Vh, KBASE((t) + 1)); SBAR(); }                                                        \
        pv_tile<VB>(o, vb0, pa0, pa1, pa2, pa3); MASKT(PX0, PX1, (t)); partialSM(PX0, PX1, m_reg, mnX, alX);                  \
        __syncthreads();                                                                                                      \
        if ((t) + 1 < NT) { VMW(); SWRITE_H(SB); }                                                                            \
        RESC(alX); __syncthreads(); } while (0)
    for (int t = 1; t + 1 < NT; t += 2) {
        HALF_STEP(pB0, pB1, mnB, alB, pA0, pA1, alA, t, 1, 0, 0);
        HALF_STEP(pA0, pA1, mnA, alA, pB0, pB1, alB, t + 1, 0, 1, 1);
    }
    const bool even = (NT & 1) == 0;
    if (even) { SBAR(); qkt<1>(pB0, pB1, K_lds, r32, hi, S.qr); SBAR(); }
    SLOAD_H(nxt.K, nxt.V, 0); SBAR();
#pragma unroll
    for (int d0 = 0; d0 < 4; ++d0) S.qr[d0] = load8(nxt.Q + (size_t)(wid * QBLK + r32) * PQ + d0 * 16 + hi * 8);
    SBAR();
    finishSM(pA0, pA1, alA, l_reg, pa0, pa1, pa2, pa3); SBAR();
    pv_tile<0>(o, vb0, pa0, pa1, pa2, pa3);
    if (even) { MASKT(pB0, pB1, NT - 1); partialSM(pB0, pB1, m_reg, mnB, alB); __syncthreads(); RESC(alB);
        finishSM(pB0, pB1, alB, l_reg, pa0, pa1, pa2, pa3); SBAR(); pv_tile<1>(o, vb0, pa0, pa1, pa2, pa3); }
    SBAR(); SEAM_K0();
    if (hi == 0) li_l[r32] = l_reg; asm volatile("s_waitcnt lgkmcnt(0)" ::: "memory");
    float rli[16];
#pragma unroll
    for (int r = 0; r < 16; ++r) rli[r] = __builtin_amdgcn_rcpf(li_l[crow(r, hi)]);
    bf16_t* Ow = cur.O + (size_t)(wid * QBLK) * PO;
#pragma unroll
    for (int r = 0; r < 16; ++r) { const int orow = crow(r, hi);
#pragma unroll
        for (int d0 = 0; d0 < 4; ++d0) { const float v = o[d0][r] * rli[r];
            const float vn = __shfl_xor(v, 1);
            if ((r32 & 1) == 0) *(unsigned*)(Ow + (size_t)orow * PO + d0 * 32 + r32) = cvtpk(v, vn); } }
    __syncthreads();
#undef RESC
#undef KBASE
#undef MASKT
#undef SEAM_K0
#undef HALF_STEP
}
#undef VMW
#undef VMWN
#undef SLOAD_H
#undef SWRITE_HK
#undef SWRITE_HV
#undef SWRITE_H
__device__ __forceinline__ BlockRef ref_of(int s, int v, int G, const bf16_t* Q, const bf16_t* K, const bf16_t* V, bf16_t* O) {
    const int L = v + (s >> 1) * G; const int b = (L >> 5) & 7, idx = (L & 31) + 32 * (L >> 8), vh = idx >> 4, y = idx & 15;
    const int qb = (s & 1) ? (NQB - 1 - y) : y; const int h = vh >> 1, m = vh & 1;
    const size_t rb = (size_t)b * SEQ;
    BlockRef r;
    r.Q = Q + (rb + (size_t)qb * QB) * PQ + h * 128 + m * 64; r.K = K + rb * PQ + h * 128 + m * 64; r.V = V + rb * PQ + h * 128;
    r.O = O + (rb + (size_t)qb * QB) * PO + h * 256 + m * 128; r.P0 = qb * QB; return r;
}
__device__ __forceinline__ void attn_phase(char* lds, const bf16_t* Q, const bf16_t* K, const bf16_t* V, bf16_t* O, int v, int G) {
    constexpr int TOTAL = NB * 8 * (NQB / 2);
    if (v >= TOTAL) return;
    const int nitems = (TOTAL - v + G - 1) / G, ns = 2 * nitems;
    BlockRef cur = ref_of(0, v, G, Q, K, V, O);
    Seam S;
    prime(cur, lds, S);
    for (int s = 0; s < ns; ++s) {
        const BlockRef nxt = (s + 1 < ns) ? ref_of(s + 1, v, G, Q, K, V, O) : cur;
        block(cur, nxt, lds, S);
        cur = nxt;
    }
}
#undef KSWZ
#undef SBAR
}
struct Frame {
    LAS unsigned char* lds;
    volatile LAS unsigned* MISC;
    gu32* ctl;
    int tid, lane, wave, vcu, G;
    float* out; unsigned char* ws;
};
enum { I_X = 0, I_C, I_WADA, I_BADA, I_WIN, I_LQ1, I_LK1, I_LQ2, I_LK2, I_SUBLN, I_SGG, I_SGB, I_WSP, I_BSP, I_WOUT, I_LN1G, I_LN1B, I_WGRP, I_BGRP, I_WRT, I_BRT, I_WGATE, I_WUP, I_WDOWN, I_LN2G, I_LN2B };

__device__ __forceinline__ const float* in_ptr(int i) {
    const __attribute__((address_space(4))) char* kp = (const __attribute__((address_space(4))) char*)__builtin_amdgcn_kernarg_segment_ptr();
    asm volatile("" : "+s"(kp));
    return *(const float* const __attribute__((address_space(4)))*)(kp + 8 * i);
}
#define INP(i) in_ptr(i)
#define OPAQUE_IDS(F) do { asm volatile("" : "+v"(F.tid)); F.lane = F.tid & 63; F.wave = __builtin_amdgcn_readfirstlane(F.tid >> 6); } while (0)
__constant__ float INVF[32] = {1.000000000e+00f, 7.498942018e-01f, 5.623413324e-01f, 4.216965139e-01f, 3.162277639e-01f, 2.371373922e-01f, 1.778279394e-01f, 1.333521456e-01f, 1.000000015e-01f, 7.498941571e-02f, 5.623412877e-02f, 4.216964915e-02f, 3.162277862e-02f, 2.371373586e-02f, 1.778279431e-02f, 1.333521493e-02f, 9.999999776e-03f, 7.498942316e-03f, 5.623413250e-03f, 4.216964822e-03f, 3.162277862e-03f, 2.371373819e-03f, 1.778279431e-03f, 1.333521446e-03f, 1.000000047e-03f, 7.498941850e-04f, 5.623413017e-04f, 4.216965463e-04f, 3.162277862e-04f, 2.371373848e-04f, 1.778279402e-04f, 1.333521504e-04f};
__device__ __forceinline__ void sincos_d(double x, double& s, double& c) {
    const double k = __builtin_rint(x * 0.63661977236758134308); const int q = (int)k & 3;
    double r = __builtin_fma(-k, 1.57079632679489655800e+00, x); r = __builtin_fma(-k, 6.12323399573676603587e-17, r);
    const double r2 = r * r;
    double sp = -1.0 / 1307674368000.0; sp = sp * r2 + 1.0 / 6227020800.0; sp = sp * r2 - 1.0 / 39916800.0; sp = sp * r2 + 1.0 / 362880.0; sp = sp * r2 - 1.0 / 5040.0; sp = sp * r2 + 1.0 / 120.0; sp = sp * r2 - 1.0 / 6.0; sp = sp * r2 * r + r;
    double cp = 1.0 / 20922789888000.0; cp = cp * r2 - 1.0 / 87178291200.0; cp = cp * r2 + 1.0 / 479001600.0; cp = cp * r2 - 1.0 / 3628800.0; cp = cp * r2 + 1.0 / 40320.0; cp = cp * r2 - 1.0 / 720.0; cp = cp * r2 + 1.0 / 24.0; cp = cp * r2 - 0.5; cp = cp * r2 + 1.0;
    s = (q == 0) ? sp : (q == 1) ? cp : (q == 2) ? -sp : -cp;
    c = (q == 0) ? cp : (q == 1) ? -sp : (q == 2) ? -cp : sp;
}
__device__ __forceinline__ int c5_of_s5(int s) { return ((s & 0x18) >> 1) | ((s & 4) << 2) | (s & 3); }
__device__ __forceinline__ int map_store(int n) { return (n & ~31) | c5_of_s5(n & 31); }
__device__ __forceinline__ int map_inproj(int n) { if (n < 1024) { const int b4 = (n >> 4) & 1, b5 = (n >> 5) & 1; return (n & ~0x30) | (b4 << 5) | (b5 << 4); } return map_store(n); }
__device__ __forceinline__ int map_gateup(int hh, int up) { return 256 * (hh >> 7) + 128 * ((hh >> 2) & 1) + 32 * ((hh >> 5) & 3) + 16 * up + 4 * ((hh >> 3) & 3) + (hh & 3); }

template <int MAP>
__device__ __forceinline__ void p0_transpose_item(const float* W, int K, int N, bf16_t* WT, LAS float* scr, int item, int lane) {
    const int nblk = N / 32, kb = item / nblk, nb = item % nblk, k0 = 64 * kb, n0 = 32 * nb;
#pragma unroll 8
    for (int i = 0; i < 32; ++i) { const int kk = 2 * i + (lane >> 5); scr[kk * 33 + (lane & 31)] = W[(size_t)(k0 + kk) * N + n0 + (lane & 31)]; }
    LDS_WAIT(); asm volatile("" ::: "memory");
    const int c = lane & 7;
#pragma unroll
    for (int j = 0; j < 4; ++j) { const int n = (lane >> 3) + 8 * j; const LAS float* s = scr + (8 * c) * 33 + n;
        u32x4 o; o.x = cvtpk(s[0 * 33], s[1 * 33]); o.y = cvtpk(s[2 * 33], s[3 * 33]); o.z = cvtpk(s[4 * 33], s[5 * 33]); o.w = cvtpk(s[6 * 33], s[7 * 33]);
        const int src = n0 + n;
        const int dst = (MAP == 0) ? src : (MAP == 1) ? map_inproj(src) : (MAP == 2) ? map_store(src) : (MAP == 3) ? map_gateup(src, 0) : map_gateup(src, 1);
        *(GAS u32x4*)(WT + (size_t)dst * K + k0 + 8 * c) = o; }
    LDS_WAIT(); asm volatile("" ::: "memory");
}
__device__ __forceinline__ void p0_mod_item(Frame& F, int item) {
    const int l = item / 24, cg = item % 24;
    LAS float* sil = (LAS float*)F.lds;
    LAS float* red = (LAS float*)(F.lds + 32768);
    for (int i = F.tid; i < NB * DM; i += NWAVES * 64) { const float cv = INP(I_C)[i]; sil[i] = cv / (1.0f + __expf(-cv)); }
    __syncthreads();
    const float* W = INP(I_WADA) + (size_t)l * DM * 6144 + cg * 256 + 4 * F.lane;
    f32x4 acc[NB];
#pragma unroll
    for (int b = 0; b < NB; ++b) acc[b] = (f32x4){0.f, 0.f, 0.f, 0.f};
    const int k0 = F.wave * 128;
#pragma unroll 4
    for (int k = 0; k < 128; ++k) { const f32x4 wv = *(const f32x4*)(W + (size_t)(k0 + k) * 6144);
#pragma unroll
        for (int b = 0; b < NB; ++b) acc[b] += wv * sil[b * DM + k0 + k]; }
#pragma unroll
    for (int b = 0; b < NB; ++b) *(LAS f32x4*)(red + (F.wave * NB + b) * 256 + 4 * F.lane) = acc[b];
    __syncthreads();
    float* mod = (float*)(F.ws + WS_MOD) + (size_t)l * NB * 6144;
    for (int o = F.tid; o < NB * 256; o += NWAVES * 64) { const int b = o >> 8, n = o & 255; float s = INP(I_BADA)[l * 6144 + cg * 256 + n];
#pragma unroll
        for (int w = 0; w < NWAVES; ++w) s += red[(w * NB + b) * 256 + n];
        mod[b * 6144 + cg * 256 + n] = s; }
    __syncthreads();
}
__device__ __forceinline__ void p0_prologue(Frame& F) {
    OPAQUE_IDS(F);
    if (blockIdx.x < 48) p0_mod_item(F, (int)blockIdx.x);
    const int gt = (int)blockIdx.x * NWAVES * 64 + F.tid, NGT = F.G * NWAVES * 64;
    { float* cosT = (float*)(F.ws + WS_COS); float* sinT = (float*)(F.ws + WS_SIN);
      for (int i = gt; i < SEQ * 32; i += NGT) { const int pos = i >> 5, f = i & 31;
          const float ang = (float)pos * INVF[f]; double sv, cv; sincos_d((double)ang, sv, cv);
          cosT[i] = (float)cv; sinT[i] = (float)sv; } }
    if (blockIdx.x == 48 && F.tid < DEPTH) { const int l = F.tid; float s1 = 0.f, s2 = 0.f; const float* q1 = INP(I_LQ1); const float* k1 = INP(I_LK1); const float* q2 = INP(I_LQ2); const float* k2 = INP(I_LK2);
        for (int i = 0; i < 64; ++i) { s1 += q1[l * 64 + i] * k1[l * 64 + i]; s2 += q2[l * 64 + i] * k2[l * 64 + i]; }
        const float lam_init = 0.8f - 0.6f * expf(-0.3f * (float)l);
        float* sc = (float*)(F.ws + WS_SCAL) + l * 4; sc[0] = expf(s1) - expf(s2) + lam_init; sc[1] = 1.0f - lam_init; sc[2] = 0.f; sc[3] = 0.f; }
    { bf16_t* wsp = (bf16_t*)(F.ws + WS_WSP);
      for (int i = gt; i < DEPTH * 4 * 128 * 128 / 2; i += NGT) { const int e0 = 2 * i, s = e0 & 127, t = (e0 >> 7) & 127;
          const float a = (s <= t) ? INP(I_WSP)[e0] : 0.f, b = (s + 1 <= t) ? INP(I_WSP)[e0 + 1] : 0.f; ((unsigned*)wsp)[i] = cvtpk(a, b); } }
    { const int gw = (int)blockIdx.x * NWAVES + F.wave, NGW = F.G * NWAVES;
      for (int it = gw; it < DEPTH * 96; it += NGW) { const int l = it / 96, f = it % 96, blk = f % 3, gs = f / 3, g = gs >> 2, s = gs & 3;
          const int i = F.lane & 15, q = F.lane >> 4, kb = 128 * g + 32 * q + 8 * s; float v[8];
#pragma unroll
          for (int j = 0; j < 8; ++j) { const int k = kb + j; float x = 0.f;
              if (blk < 2) { const int Gp = 2 * blk + (i >> 3), e = i & 7; x = INP(I_WRT)[(((size_t)l * 4 + Gp) * DM + k) * 8 + e]; }
              else if (i < 4) x = INP(I_WGRP)[((size_t)l * DM + k) * 4 + i];
              v[j] = x; }
          u32x4 o; o.x = cvtpk(v[0], v[1]); o.y = cvtpk(v[2], v[3]); o.z = cvtpk(v[4], v[5]); o.w = cvtpk(v[6], v[7]);
          *((u32x4*)(F.ws + WS_RIMG) + (size_t)it * 64 + F.lane) = o; } }
    LAS float* scr = (LAS float*)(F.lds + F.wave * 16384);
    const int gw = (int)blockIdx.x * NWAVES + F.wave, NGW = F.G * NWAVES;
    constexpr int I_IN = 16 * 80, I_OUT = 16 * 32, I_G = 32 * 256, I_D = 32 * 256, PER_L = I_IN + I_OUT + 2 * I_G + I_D;
    for (int it = gw; it < DEPTH * PER_L; it += NGW) {
        const int l = it / PER_L; int r = it % PER_L;
        if (r < I_IN) { p0_transpose_item<1>(INP(I_WIN) + (size_t)l * DM * INC, DM, INC, (bf16_t*)(F.ws + WS_WIN) + (size_t)l * INC * DM, scr, r, F.lane); continue; } r -= I_IN;
        if (r < I_OUT) { p0_transpose_item<0>(INP(I_WOUT) + (size_t)l * DM * DM, DM, DM, (bf16_t*)(F.ws + WS_WOUT) + (size_t)l * DM * DM, scr, r, F.lane); continue; } r -= I_OUT;
        if (r < I_G) { const int e = r >> 8; p0_transpose_item<3>(INP(I_WGATE) + ((size_t)l * NEXP + e) * DM * DEXP, DM, DEXP, (bf16_t*)(F.ws + WS_WGU) + ((size_t)l * NEXP + e) * 1024 * DM, scr, r & 255, F.lane); continue; } r -= I_G;
        if (r < I_G) { const int e = r >> 8; p0_transpose_item<4>(INP(I_WUP) + ((size_t)l * NEXP + e) * DM * DEXP, DM, DEXP, (bf16_t*)(F.ws + WS_WGU) + ((size_t)l * NEXP + e) * 1024 * DM, scr, r & 255, F.lane); continue; } r -= I_G;
        { const int e = r >> 8; p0_transpose_item<2>(INP(I_WDOWN) + ((size_t)l * NEXP + e) * DEXP * DM, DEXP, DM, (bf16_t*)(F.ws + WS_WD) + ((size_t)l * NEXP + e) * DM * DEXP, scr, r & 255, F.lane); }
    }
}
__device__ __forceinline__ void store_bf16_row(bf16_t* orow, const f32x4 (&v)[4], int lane) {
    GAS u32x2* o8 = (GAS u32x2*)orow + lane;
#pragma unroll
    for (int j = 0; j < 4; ++j) { u32x2 w; w.x = cvtpk(v[j].x, v[j].y); w.y = cvtpk(v[j].z, v[j].w); o8[64 * j] = w; }
}
__device__ __forceinline__ void p1_htransform(Frame& F) {
    OPAQUE_IDS(F);
    const int gw = F.vcu * NWAVES + F.wave, NGW = F.G * NWAVES;
    const float* mod = (const float*)(F.ws + WS_MOD);
    for (int m = gw; m < MTOK; m += NGW) { const int b = m >> 13; const GAS f32x4* xr = (const GAS f32x4*)(INP(I_X) + (size_t)m * DM) + F.lane;
        const GAS f32x4* sh = (const GAS f32x4*)(mod + b * 6144) + F.lane; const GAS f32x4* sc = (const GAS f32x4*)(mod + b * 6144 + 1024) + F.lane;
        f32x4 v[4];
#pragma unroll
        for (int j = 0; j < 4; ++j) v[j] = xr[64 * j] * (sc[64 * j] + 1.0f) + sh[64 * j];
        store_bf16_row((bf16_t*)(F.ws + WS_HB) + (size_t)m * DM, v, F.lane); }
}
__device__ __forceinline__ void ln_row(f32x4 (&v)[4], const float* g, const float* bta, int lane) {
    float s = 0.f;
#pragma unroll
    for (int j = 0; j < 4; ++j) s += (v[j].x + v[j].y) + (v[j].z + v[j].w);
    const float mean = wave_sum(s) * (1.f / DM); float s2 = 0.f;
#pragma unroll
    for (int j = 0; j < 4; ++j) { v[j] = v[j] - mean; s2 += (v[j].x * v[j].x + v[j].y * v[j].y) + (v[j].z * v[j].z + v[j].w * v[j].w); }
    const float rstd = 1.f / sqrtf(wave_sum(s2) * (1.f / DM) + LN_EPS);
#pragma unroll
    for (int j = 0; j < 4; ++j) { const f32x4 gg = *((const f32x4*)g + lane + 64 * j), bb = *((const f32x4*)bta + lane + 64 * j); v[j] = v[j] * rstd * gg + bb; }
}
__device__ __forceinline__ void p_ln1(Frame& F, int l) {
    OPAQUE_IDS(F);
    const int gw = F.vcu * NWAVES + F.wave, NGW = F.G * NWAVES;
    const float* mod = (const float*)(F.ws + WS_MOD) + (size_t)l * NB * 6144;
    for (int m = gw; m < MTOK; m += NGW) { const int b = m >> 13; GAS f32x4* xr = (GAS f32x4*)(F.out + (size_t)m * DM) + F.lane;
        f32x4 v[4];
#pragma unroll
        for (int j = 0; j < 4; ++j) v[j] = xr[64 * j];
        ln_row(v, INP(I_LN1G) + l * DM, INP(I_LN1B) + l * DM, F.lane);
#pragma unroll
        for (int j = 0; j < 4; ++j) xr[64 * j] = v[j];
        const GAS f32x4* sh = (const GAS f32x4*)(mod + b * 6144 + 3072) + F.lane; const GAS f32x4* sc = (const GAS f32x4*)(mod + b * 6144 + 4096) + F.lane;
#pragma unroll
        for (int j = 0; j < 4; ++j) v[j] = v[j] * (sc[64 * j] + 1.0f) + sh[64 * j];
        store_bf16_row((bf16_t*)(F.ws + WS_HB) + (size_t)m * DM, v, F.lane); }
}
__device__ __forceinline__ void p_ln2(Frame& F, int l) {
    OPAQUE_IDS(F);
    const int gw = F.vcu * NWAVES + F.wave, NGW = F.G * NWAVES;
    const float* mod = (const float*)(F.ws + WS_MOD) + (size_t)l * NB * 6144;
    const bf16_t* y2 = (const bf16_t*)(F.ws + WS_Y2);
    for (int m = gw; m < MTOK; m += NGW) { const int b = m >> 13; GAS f32x4* xr = (GAS f32x4*)(F.out + (size_t)m * DM) + F.lane;
        const GAS u32x2* ya = (const GAS u32x2*)(y2 + (size_t)m * 2 * DM) + F.lane; const GAS u32x2* yb = ya + 256;
        const GAS f32x4* gt = (const GAS f32x4*)(mod + b * 6144 + 5120) + F.lane;
        f32x4 v[4];
#pragma unroll
        for (int j = 0; j < 4; ++j) { const u32x2 a = ya[64 * j], c = yb[64 * j];
            const f32x4 f = (f32x4){bflo(a.x) + bflo(c.x), bfhi(a.x) + bfhi(c.x), bflo(a.y) + bflo(c.y), bfhi(a.y) + bfhi(c.y)};
            v[j] = xr[64 * j] * ALPHA + (gt[64 * j] + 1.0f) * f; }
        ln_row(v, INP(I_LN2G) + l * DM, INP(I_LN2B) + l * DM, F.lane);
#pragma unroll
        for (int j = 0; j < 4; ++j) xr[64 * j] = v[j];
        if (l + 1 < DEPTH) { const float* mod1 = mod + NB * 6144;
            const GAS f32x4* sh = (const GAS f32x4*)(mod1 + b * 6144) + F.lane; const GAS f32x4* sc = (const GAS f32x4*)(mod1 + b * 6144 + 1024) + F.lane;
#pragma unroll
            for (int j = 0; j < 4; ++j) v[j] = v[j] * (sc[64 * j] + 1.0f) + sh[64 * j];
            store_bf16_row((bf16_t*)(F.ws + WS_HB) + (size_t)m * DM, v, F.lane); } }
}
__device__ __forceinline__ void p_diffnorm(Frame& F, int l) {
    OPAQUE_IDS(F);
    const int gw = F.vcu * NWAVES + F.wave, NGW = F.G * NWAVES;
    const float lam = __uint_as_float(__hip_atomic_load((const unsigned*)(F.ws + WS_SCAL) + l * 4, RLX_AGENT)), oml = __uint_as_float(__hip_atomic_load((const unsigned*)(F.ws + WS_SCAL) + l * 4 + 1, RLX_AGENT));
    const bf16_t* o12 = (const bf16_t*)(F.ws + WS_O12); bf16_t* mix = (bf16_t*)(F.ws + WS_MIXA);
    const int h = F.lane >> 4, j = F.lane & 15;
    const f32x4 g0 = *(const f32x4*)(INP(I_SUBLN) + l * 128 + 8 * j) * oml, g1 = *(const f32x4*)(INP(I_SUBLN) + l * 128 + 8 * j + 4) * oml;
    for (int m = gw; m < MTOK; m += NGW) {
        const u32x4 a = *(const GAS u32x4*)(o12 + (size_t)m * 1024 + h * 256 + 8 * j), c = *(const GAS u32x4*)(o12 + (size_t)m * 1024 + h * 256 + 128 + 8 * j);
        f32x4 d0 = (f32x4){bflo(a.x) - lam * bflo(c.x), bfhi(a.x) - lam * bfhi(c.x), bflo(a.y) - lam * bflo(c.y), bfhi(a.y) - lam * bfhi(c.y)};
        f32x4 d1 = (f32x4){bflo(a.z) - lam * bflo(c.z), bfhi(a.z) - lam * bfhi(c.z), bflo(a.w) - lam * bflo(c.w), bfhi(a.w) - lam * bfhi(c.w)};
        float ss = (d0.x * d0.x + d0.y * d0.y) + (d0.z * d0.z + d0.w * d0.w) + (d1.x * d1.x + d1.y * d1.y) + (d1.z * d1.z + d1.w * d1.w);
        ss += __shfl_xor(ss, 1); ss += __shfl_xor(ss, 2); ss += __shfl_xor(ss, 4); ss += __shfl_xor(ss, 8);
        const float rs = 1.f / sqrtf(ss * (1.f / 128.f) + LN_EPS);
        d0 = d0 * rs * g0; d1 = d1 * rs * g1;
        *(GAS u32x4*)(mix + (size_t)m * 1024 + h * 128 + 8 * j) = pg8::pack8(d0, d1); }
}
__device__ __forceinline__ void p_sg(Frame& F, int l) {
    OPAQUE_IDS(F);
    constexpr int ZS = 136;
    LAS bf16_t* zT = (LAS bf16_t*)F.lds;
    const bf16_t* Zb = (const bf16_t*)(F.ws + WS_Q + 4 * WS_QSTRIDE); const bf16_t* Ub = (const bf16_t*)(F.ws + WS_Q + 3 * WS_QSTRIDE);
    bf16_t* mix = (bf16_t*)(F.ws + WS_MIXA);
    const int r32 = F.lane & 31, hi = F.lane >> 5;
    for (int u = F.vcu; u < (MTOK / 128) * 4; u += F.G) { const int n = u >> 2, g = u & 3;
        { const int s = F.tid >> 2, qd = F.tid & 3; const bf16_t* zp = Zb + (size_t)(n * 128 + s) * 512 + g * 128 + qd * 32;
          u32x4 raw[4]; float x[32];
#pragma unroll
          for (int i = 0; i < 4; ++i) raw[i] = *(const GAS u32x4*)(zp + 8 * i);
#pragma unroll
          for (int i = 0; i < 4; ++i) { x[8 * i + 0] = bflo(raw[i].x); x[8 * i + 1] = bfhi(raw[i].x); x[8 * i + 2] = bflo(raw[i].y); x[8 * i + 3] = bfhi(raw[i].y);
              x[8 * i + 4] = bflo(raw[i].z); x[8 * i + 5] = bfhi(raw[i].z); x[8 * i + 6] = bflo(raw[i].w); x[8 * i + 7] = bfhi(raw[i].w); }
          float sm = 0.f;
#pragma unroll
          for (int i = 0; i < 32; ++i) sm += x[i];
          sm += __shfl_xor(sm, 1); sm += __shfl_xor(sm, 2); const float mean = sm * (1.f / 128.f); float sq = 0.f;
#pragma unroll
          for (int i = 0; i < 32; ++i) { x[i] -= mean; sq += x[i] * x[i]; }
          sq += __shfl_xor(sq, 1); sq += __shfl_xor(sq, 2); const float rstd = 1.f / sqrtf(sq * (1.f / 128.f) + LN_EPS);
          const float* lg = INP(I_SGG) + (l * 4 + g) * 128 + qd * 32; const float* lb = INP(I_SGB) + (l * 4 + g) * 128 + qd * 32;
#pragma unroll
          for (int i = 0; i < 32; ++i) { const float zn = x[i] * rstd * lg[i] + lb[i]; zT[(qd * 32 + i) * ZS + s] = (bf16_t)(cvtpk(zn, 0.f) & 0xffffu); } }
        __syncthreads();
        { const int cb = F.wave & 3, tb0 = 2 * (F.wave >> 2);
          const bf16_t* Wg = (const bf16_t*)(F.ws + WS_WSP) + (size_t)(l * 4 + g) * 128 * 128;
          f32x16 acc[2]; acc[0] = f32x16{}; acc[1] = f32x16{};
#pragma unroll
          for (int ks = 0; ks < 8; ++ks) { const bf16x8 a = *(const LAS bf16x8*)(zT + (cb * 32 + r32) * ZS + ks * 16 + hi * 8);
#pragma unroll
              for (int tb = 0; tb < 2; ++tb) { if (ks <= 2 * (tb0 + tb) + 1) { const bf16x8 bw = *(const GAS bf16x8*)(Wg + (size_t)((tb0 + tb) * 32 + r32) * 128 + ks * 16 + hi * 8);
                  acc[tb] = __builtin_amdgcn_mfma_f32_32x32x16_bf16(a, bw, acc[tb], 0, 0, 0); } } }
#pragma unroll
          for (int tb = 0; tb < 2; ++tb) { const int t = (tb0 + tb) * 32 + r32; const float bs = INP(I_BSP)[(l * 4 + g) * 128 + t];
              const size_t row = (size_t)(n * 128 + t);
#pragma unroll
              for (int r4 = 0; r4 < 4; ++r4) { const int c = cb * 32 + 8 * r4 + 4 * hi;
                  const u32x2 zu = *(const GAS u32x2*)(Ub + row * 512 + g * 128 + c);
                  u32x2 o; o.x = cvtpk(bflo(zu.x) * (acc[tb][4 * r4 + 0] + bs), bfhi(zu.x) * (acc[tb][4 * r4 + 1] + bs));
                  o.y = cvtpk(bflo(zu.y) * (acc[tb][4 * r4 + 2] + bs), bfhi(zu.y) * (acc[tb][4 * r4 + 3] + bs));
                  *(GAS u32x2*)(mix + row * 1024 + 512 + g * 128 + c) = o; } } }
        __syncthreads();
    }
}
__device__ __forceinline__ void p_router(Frame& F, int l) {
    OPAQUE_IDS(F);
    constexpr int LS = 41;
    LAS float* lg = (LAS float*)F.lds + F.wave * (32 * LS);
    LAS int* hist = (LAS int*)(F.lds + 65536); LAS int* base = hist + 32;
    const bf16_t* hb = (const bf16_t*)(F.ws + WS_HB);
    const u32x4* img = (const u32x4*)(F.ws + WS_RIMG) + (size_t)l * 96 * 64;
    unsigned* lst = (unsigned*)(F.ws + WS_LST); float* cwp = (float*)(F.ws + WS_CW);
    const int j = F.lane & 15, q = F.lane >> 4;
    for (int tile = F.vcu; tile < MTOK / 256; tile += F.G) {
        if (F.tid < 32) hist[F.tid] = 0;
        const int tok0 = tile * 256 + F.wave * 32;
        f32x4 acc[3][2];
#pragma unroll
        for (int b = 0; b < 3; ++b)
#pragma unroll
            for (int c = 0; c < 2; ++c) acc[b][c] = (f32x4){0.f, 0.f, 0.f, 0.f};
#pragma unroll 2
        for (int g = 0; g < 8; ++g) { bf16x8 tf[2][4];
#pragma unroll
            for (int cb = 0; cb < 2; ++cb) { const bf16_t* p = hb + (size_t)(tok0 + 16 * cb + j) * DM + 128 * g + 32 * q;
#pragma unroll
                for (int s = 0; s < 4; ++s) tf[cb][s] = *(const GAS bf16x8*)(p + 8 * s); }
#pragma unroll
            for (int s = 0; s < 4; ++s)
#pragma unroll
                for (int blk = 0; blk < 3; ++blk) { const u32x4 wv = img[((g * 4 + s) * 3 + blk) * 64 + F.lane]; const bf16x8 wf = __builtin_bit_cast(bf16x8, wv);
#pragma unroll
                    for (int cb = 0; cb < 2; ++cb) acc[blk][cb] = __builtin_amdgcn_mfma_f32_16x16x32_bf16(wf, tf[cb][s], acc[blk][cb], 0, 0, 0); } }
#pragma unroll
        for (int cb = 0; cb < 2; ++cb) {
#pragma unroll
            for (int r = 0; r < 4; ++r) { lg[(16 * cb + j) * LS + 4 * q + r] = acc[0][cb][r]; lg[(16 * cb + j) * LS + 16 + 4 * q + r] = acc[1][cb][r]; if (q == 0) lg[(16 * cb + j) * LS + 32 + r] = acc[2][cb][r]; } }
        __syncthreads();
        int E1 = 0, E2 = 0, r1 = 0, r2 = 0; float c1 = 0.f, c2 = 0.f;
        if (F.lane < 32) { const LAS float* my = lg + F.lane * LS;
            float gl[4];
#pragma unroll
            for (int i = 0; i < 4; ++i) gl[i] = my[32 + i] + INP(I_BGRP)[l * 4 + i];
            float best = gl[0]; int gi = 0;
#pragma unroll
            for (int i = 1; i < 4; ++i) if (gl[i] > best) { best = gl[i]; gi = i; }
            float den = 0.f;
#pragma unroll
            for (int i = 0; i < 4; ++i) den += __expf(gl[i] - best);
            const float gp = 1.0f / den;
            float sel[8];
#pragma unroll
            for (int e = 0; e < 8; ++e) sel[e] = my[gi * 8 + e] + INP(I_BRT)[(l * 4 + gi) * 8 + e];
            float v1 = sel[0]; int i1 = 0;
#pragma unroll
            for (int e = 1; e < 8; ++e) if (sel[e] > v1) { v1 = sel[e]; i1 = e; }
            float v2 = -__builtin_inff(); int i2 = 0;
#pragma unroll
            for (int e = 0; e < 8; ++e) if (e != i1 && sel[e] > v2) { v2 = sel[e]; i2 = e; }
            const float w1 = 1.0f / (1.0f + __expf(v2 - v1)), w2 = 1.0f - w1;
            c1 = gp * w1; c2 = gp * w2; E1 = gi * 8 + i1; E2 = gi * 8 + i2;
            r1 = __hip_atomic_fetch_add(hist + E1, 1, __ATOMIC_RELAXED, __HIP_MEMORY_SCOPE_WORKGROUP);
            r2 = __hip_atomic_fetch_add(hist + E2, 1, __ATOMIC_RELAXED, __HIP_MEMORY_SCOPE_WORKGROUP); }
        __syncthreads();
        if (F.tid < 32) base[F.tid] = (int)__hip_atomic_fetch_add((unsigned*)(F.ctl + CW_CNT + l * 32 + F.tid), (unsigned)hist[F.tid], RLX_AGENT);
        __syncthreads();
        if (F.lane < 32) { const unsigned tok = (unsigned)(tok0 + F.lane);
            const size_t p1 = (size_t)E1 * LCAP + base[E1] + r1, p2 = (size_t)E2 * LCAP + base[E2] + r2;
            lst[p1] = tok * 2u; cwp[p1] = c1; lst[p2] = tok * 2u + 1u; cwp[p2] = c2; }
        __syncthreads();
    }
}
__device__ __forceinline__ int expert_setup(Frame& F, int l, bool fill_idx) {
    OPAQUE_IDS(F);
    LAS int* ppre = (LAS int*)(F.lds + PPRE_OFF); LAS int* cnt = ppre + 40;
    if (F.tid < 32) cnt[F.tid] = (int)__hip_atomic_load((unsigned*)(F.ctl + CW_CNT + l * 32 + F.tid), RLX_AGENT);
    __syncthreads();
    if (F.tid == 0) { int s = 0; for (int e = 0; e < NEXP; ++e) { ppre[e] = s; s += (cnt[e] + 255) >> 8; } ppre[NEXP] = s; }
    __syncthreads();
    const int TP = ppre[NEXP];
    if (fill_idx) { LAS unsigned* idx = (LAS unsigned*)(F.lds + IDX_OFF); const unsigned* lst = (const unsigned*)(F.ws + WS_LST);
        for (int i = 0; i < IDX_SLOTS; ++i) { const int L = i * F.G + (int)blockIdx.x; if (L >= 4 * TP) break;
            const int p = L >> 2; int e = 0; while (e < NEXP - 1 && ppre[e + 1] <= p) ++e;
            const int row0 = (p - ppre[e]) * 256, rem = cnt[e] - row0;
            if (F.tid < 256) idx[i * 256 + F.tid] = (F.tid < rem) ? (lst[(size_t)e * LCAP + row0 + F.tid] >> 1) : 0u; }
        __syncthreads(); }
    return TP;
}
#define XB_TMO      128
#define XB_XCNT(j)  (256  + 64 * (j))
#define XB_XSUB(j)  (1280 + 64 * (j))
#define XB_XGEN(j)  (2304 + 64 * (j))
#define XB_TOP      3328
#define XB_TOPGEN   3392
#define XCD_BAR_WORDS 3456
#define XB_SPIN_CAP (1u << 18)

__device__ __forceinline__ unsigned xb_ld(unsigned* p)              { return __hip_atomic_load(p, __ATOMIC_RELAXED, __HIP_MEMORY_SCOPE_AGENT); }
__device__ __forceinline__ unsigned xb_add(unsigned* p, unsigned v) { return __hip_atomic_fetch_add(p, v, __ATOMIC_RELAXED, __HIP_MEMORY_SCOPE_AGENT); }
__device__ __forceinline__ unsigned xb_xcc_id() { return (unsigned)__builtin_amdgcn_s_getreg((3 << 11) | 20) & 0xFu; }
#define XB_SPIN(cond, bar) do { unsigned _sp = 0; while (cond) { __builtin_amdgcn_s_sleep(1); \
    if ((++_sp & 255u) == 0u) { if (xb_ld(&(bar)[XB_TMO])) break; if (_sp > XB_SPIN_CAP) { atomicAdd(&(bar)[XB_TMO], 1u); break; } } } } while (0)

struct XcdBarrier {
    unsigned* bar; unsigned x;
    volatile LAS unsigned* st;
};

__device__ __forceinline__ XcdBarrier xcd_barrier_post(unsigned* bar, volatile LAS unsigned* st) {
    XcdBarrier b; b.bar = bar; b.x = xb_xcc_id(); b.st = st;
    if (threadIdx.x == 0) (void)xb_add(&bar[XB_XCNT(b.x)], 1u);
    return b;
}
__device__ __forceinline__ void xcd_barrier_complete(unsigned* bar, unsigned x, unsigned& nloc, unsigned& nx) {
    const unsigned G = gridDim.x * gridDim.y * gridDim.z;
    unsigned sum, cnt, mine, sp = 0u;
    for (;;) {
        sum = 0u; cnt = 0u; mine = 0u;
#pragma unroll
        for (unsigned j = 0; j < 16; ++j) { const unsigned c = xb_ld(&bar[XB_XCNT(j)]); sum += c; cnt += (c > 0u) ? 1u : 0u; mine = (j == x) ? c : mine; }
        if (sum == G) break;
        __builtin_amdgcn_s_sleep(1);
        if ((++sp & 255u) == 0u) { if (xb_ld(&bar[XB_TMO])) break; if (sp > XB_SPIN_CAP) { atomicAdd(&bar[XB_TMO], 1u); break; } }
    }
    nloc = mine > 0u ? mine : 1u; nx = cnt > 0u ? cnt : 1u;
}

__device__ __forceinline__ void xcd_barrier(const XcdBarrier& b) {
    asm volatile("s_waitcnt vmcnt(0)" ::: "memory");
    __syncthreads();
    if (threadIdx.x == 0) {
        unsigned* bar = b.bar;
        __builtin_amdgcn_s_waitcnt(0);
        unsigned nloc = b.st[0], nx = b.st[1];
        if (nloc == 0u) { xcd_barrier_complete(bar, b.x, nloc, nx); b.st[0] = nloc; b.st[1] = nx; }
        const unsigned old = xb_add(&bar[XB_XSUB(b.x)], 1u);
        const unsigned gen = old / nloc;
        if (old + 1u == (gen + 1u) * nloc) {
            __builtin_amdgcn_fence(__ATOMIC_RELEASE, "agent");
            asm volatile("s_waitcnt vmcnt(0)" ::: "memory");
            const unsigned og = xb_add(&bar[XB_TOP], 1u);
            const unsigned tg = og / nx;
            if (og + 1u == (tg + 1u) * nx) xb_add(&bar[XB_TOPGEN], 1u);
            else XB_SPIN(xb_ld(&bar[XB_TOPGEN]) == tg, bar);
            __builtin_amdgcn_fence(__ATOMIC_ACQUIRE, "agent");
            xb_add(&bar[XB_XGEN(b.x)], 1u);
            asm volatile("s_waitcnt vmcnt(0)" ::: "memory");
        } else {
            XB_SPIN(xb_ld(&bar[XB_XGEN(b.x)]) == gen, bar);
            __builtin_amdgcn_fence(__ATOMIC_ACQUIRE, "agent");
            asm volatile("s_waitcnt vmcnt(0)" ::: "memory");
        }
    }
    __syncthreads();
}

constexpr int N_PHASES = 2 + 9 * DEPTH;
struct Args { const float* in[26]; float* out; unsigned char* ws; int ph_lo, ph_hi; };
__global__ void __launch_bounds__(NWAVES * 64, 2) hymba_fwd(Args args) {
    extern __shared__ __attribute__((aligned(16))) unsigned char lds[];
    Frame F;
    F.lds = (LAS unsigned char*)lds;
    F.MISC = (volatile LAS unsigned*)(F.lds + MISC_OFF);
    F.tid = threadIdx.x; F.lane = F.tid & 63; F.wave = __builtin_amdgcn_readfirstlane(F.tid >> 6);
    F.G = gridDim.x; { const int bx = blockIdx.x; F.vcu = (F.G % 8 == 0) ? (bx % 8) * (F.G / 8) + bx / 8 : bx; }
    F.ws = args.ws; F.out = args.out; F.ctl = (gu32*)(args.ws + WS_CTL);
    for (int u = F.tid; u < (LDS_BYTES - LDSCTL_OFF) / 4; u += NWAVES * 64) ((LAS unsigned*)(F.lds + LDSCTL_OFF))[u] = 0u;
    __syncthreads();
    const int lo = args.ph_lo, hi = args.ph_hi;
    XcdBarrier bar; bar.bar = (unsigned*)(F.ctl + CW_BAR); bar.x = 0; bar.st = nullptr;
    if (hi - lo > 1) bar = xcd_barrier_post((unsigned*)(F.ctl + CW_BAR), F.MISC + 8);
#ifndef PHMASK
#define PHMASK 0x7ff
#endif
#define PH(k) (lo <= (k) && (k) < hi)
#define PHK(k, kind) (((PHMASK >> (kind)) & 1) && lo <= (k) && (k) < hi)
#define SEAM(k) do { if (PH(k) && PH((k) + 1)) xcd_barrier(bar); } while (0)
    unsigned char* ws = args.ws;
    bf16_t* HB = (bf16_t*)(ws + WS_HB); bf16_t* QB_ = (bf16_t*)(ws + WS_Q);
    if (PHK(0, 0)) p0_prologue(F);
    SEAM(0);
    if (PHK(1, 1)) p1_htransform(F);
    SEAM(1);
    for (int l = 0; l < DEPTH; ++l) {
        const int pb = 2 + 9 * l;
        const float* mod = (const float*)(ws + WS_MOD) + (size_t)l * NB * 6144;
        if (PHK(pb + 0, 2)) {
            pg8::DenseOrder S; S.init(HB, (const bf16_t*)(ws + WS_WIN) + (size_t)l * INC * DM, MTOK, INC, DM, F.G, (int)blockIdx.x);
            pg8::EpiInProj E{QB_, WS_QSTRIDE / 2, (const float*)(ws + WS_COS), (const float*)(ws + WS_SIN), 1.0f};
            pg8::gemm_phase<pg8::EpiInProj, pg8::DenseOrder, false>(F.lds, DM, nullptr, S, E);
        }
        SEAM(pb + 0);
        if (PHK(pb + 1, 3)) {
            att::attn_phase((char*)lds, QB_, (const bf16_t*)(ws + WS_Q + WS_QSTRIDE), (const bf16_t*)(ws + WS_Q + 2 * WS_QSTRIDE), (bf16_t*)(ws + WS_O12), F.vcu, F.G);
            __syncthreads();
            p_sg(F, l);
        }
        SEAM(pb + 1);
        if (PHK(pb + 2, 4)) p_diffnorm(F, l);
        SEAM(pb + 2);
        if (PHK(pb + 3, 5)) {
            pg8::DenseOrder S; S.init(ws + WS_MIXA, (const bf16_t*)(ws + WS_WOUT) + (size_t)l * DM * DM, MTOK, DM, DM, F.G, (int)blockIdx.x);
            pg8::EpiOutProj E{l == 0 ? INP(I_X) : F.out, F.out, mod + 2048};
            pg8::gemm_phase<pg8::EpiOutProj, pg8::DenseOrder, false>(F.lds, DM, nullptr, S, E);
        }
        SEAM(pb + 3);
        if (PHK(pb + 4, 6)) p_ln1(F, l);
        SEAM(pb + 4);
        if (PHK(pb + 5, 7)) p_router(F, l);
        SEAM(pb + 5);
        if (PHK(pb + 6, 8)) {
            const int TP = expert_setup(F, l, true);
            pg8::ExpertOrder S{(const LAS int*)(F.lds + PPRE_OFF), (const LAS int*)(F.lds + PPRE_OFF) + 40, TP, F.G, (int)blockIdx.x, (const char*)HB,
                               (const char*)(ws + WS_WGU) + (size_t)l * NEXP * 1024 * DM * 2, 0, (size_t)1024 * DM * 2, (size_t)256 * DM * 2, true};
            pg8::EpiGateUp E{(bf16_t*)(ws + WS_ACT)};
            pg8::gemm_phase<pg8::EpiGateUp, pg8::ExpertOrder, true>(F.lds, DM, (const LAS unsigned*)(F.lds + IDX_OFF), S, E);
        }
        SEAM(pb + 6);
        if (PHK(pb + 7, 9)) {
            const int TP = expert_setup(F, l, false);
            pg8::ExpertOrder S{(const LAS int*)(F.lds + PPRE_OFF), (const LAS int*)(F.lds + PPRE_OFF) + 40, TP, F.G, (int)blockIdx.x, (const char*)(ws + WS_ACT),
                               (const char*)(ws + WS_WD) + (size_t)l * NEXP * DM * DEXP * 2, (size_t)256 * DEXP * 2, (size_t)DM * DEXP * 2, (size_t)256 * DEXP * 2, false};
            pg8::EpiDown E{(bf16_t*)(ws + WS_Y2), (const unsigned*)(ws + WS_LST), (const float*)(ws + WS_CW)};
            pg8::gemm_phase<pg8::EpiDown, pg8::ExpertOrder, false>(F.lds, DEXP, nullptr, S, E);
        }
        SEAM(pb + 7);
        if (PHK(pb + 8, 10)) p_ln2(F, l);
        SEAM(pb + 8);
    }
#undef PH
#undef SEAM
}

#ifndef MK_ONE_LAUNCH
#define MK_ONE_LAUNCH 1
#endif
extern "C" void kernel_launch(void* const* d_in, const int* in_sizes, int n_in, void* d_out, int out_size, void* d_ws, size_t ws_size, hipStream_t stream) {
    static int grid = 0;
    if (grid == 0) {
        if (n_in != 26 || in_sizes[0] != MTOK * DM || out_size != MTOK * DM || ws_size < WS_END) { fprintf(stderr, "kernel_launch: unexpected shapes (n_in %d, in0 %d, out %d, ws %zu); nothing launched\n", n_in, n_in > 0 ? in_sizes[0] : -1, out_size, ws_size); grid = -1; return; }
        int dev = 0, cus = 0, per_cu = 0;
        if (hipGetDevice(&dev) != hipSuccess || hipDeviceGetAttribute(&cus, hipDeviceAttributeMultiprocessorCount, dev) != hipSuccess) { grid = -1; return; }
        if (hipFuncSetAttribute((const void*)hymba_fwd, hipFuncAttributeMaxDynamicSharedMemorySize, LDS_BYTES) != hipSuccess) { fprintf(stderr, "kernel_launch: hipFuncSetAttribute failed\n"); grid = -1; return; }
        if (hipOccupancyMaxActiveBlocksPerMultiprocessor(&per_cu, (const void*)hymba_fwd, NWAVES * 64, LDS_BYTES) != hipSuccess || per_cu < 1) { fprintf(stderr, "kernel_launch: occupancy query reports %d blocks per CU\n", per_cu); }
        (void)hipGetLastError();
        grid = cus;
    }
    if (grid < 0) return;
    if (hipMemsetAsync((char*)d_ws + WS_CTL, 0, CTL_ZERO_BYTES, stream) != hipSuccess) return;
    Args a{};
    for (int i = 0; i < 26; ++i) a.in[i] = (const float*)d_in[i];
    a.out = (float*)d_out; a.ws = (unsigned char*)d_ws;
#if MK_ONE_LAUNCH
    a.ph_lo = 0; a.ph_hi = N_PHASES;
    hipLaunchKernelGGL(hymba_fwd, dim3(grid), dim3(NWAVES * 64), LDS_BYTES, stream, a);
#else
    for (int p = 0; p < N_PHASES; ++p) { a.ph_lo = p; a.ph_hi = p + 1;
        hipLaunchKernelGGL(hymba_fwd, dim3(grid), dim3(NWAVES * 64), LDS_BYTES, stream, a); }
#endif
}
```
